# Optimizing an MI355X kernel written in HIP

```python
import math
import jax, jax.numpy as jnp
from jax import lax
import numpy as np

D_MODEL = 4096
BATCH = 1
SEQ = 16384
DEPTH = 4

D_MIX = D_MODEL
HY_WIDTH = D_MIX // 2
SSM_WIDTH = D_MIX - HY_WIDTH
SSM_HEAD_DIM = 64
SSM_HEADS = SSM_WIDTH // SSM_HEAD_DIM
SSM_GROUPS = 8
SSM_STATE = 128
SSM_CHUNK = 256
SSM_XBC = SSM_WIDTH + 2 * SSM_GROUPS * SSM_STATE
SHORT_CONV = 3
HY_ORDER = 2
HY_EMB = 33
HY_FILTER_HIDDEN = 64
HY_N_SIN = 3
HY_FAST_DECAY = 0.3
HY_SLOW_DECAY = 1.5
HY_DECAY_TARGET = 1e-2
D_FF = 4 * D_MODEL
NORM_EPS = 1e-5
N_IN = 3 * HY_WIDTH + SSM_WIDTH + SSM_XBC + SSM_HEADS

kernel_name = 'hyena_mamba2_parallel_hybrid_encoder'


def _rms(x):
    xf = x.astype(jnp.float32)
    return xf * lax.rsqrt(jnp.mean(jnp.square(xf), axis=-1, keepdims=True) + NORM_EPS)


def rmsnorm(x, g):
    return (_rms(x) * g.astype(jnp.float32)).astype(x.dtype)


def dwconv_centred(u, w, b):
    K = w.shape[0]
    p = K // 2
    L = u.shape[1]
    up = jnp.pad(u, ((0, 0), (p, p), (0, 0)))
    y = w[0] * up[:, 0:L]
    for k in range(1, K):
        y = y + w[k] * up[:, k:k + L]
    return y + b


def hyena_filters(L, w1, b1, w2, b2, w3, b3, sin_freq, wout):
    f32 = jnp.float32
    t = jnp.linspace(0.0, 1.0, L, dtype=f32)[:, None]
    bands = (HY_EMB - 1) // 2
    w = 2.0 * math.pi * jnp.arange(L, dtype=f32)[:, None] / L
    f = jnp.linspace(1e-4, bands - 1, bands, dtype=f32)[None, :]
    z = jnp.concatenate([t, jnp.cos(f * w), -jnp.sin(f * w)], axis=-1)
    fr = sin_freq.astype(f32)
    h = jnp.sin(fr[0] * (z @ w1.astype(f32) + b1.astype(f32)))
    h = jnp.sin(fr[1] * (h @ w2.astype(f32) + b2.astype(f32)))
    h = jnp.sin(fr[2] * (h @ w3.astype(f32) + b3.astype(f32)))
    h = (h @ wout.astype(f32)).reshape(L, HY_ORDER, 2, HY_WIDTH)
    deltas = jnp.linspace(math.log(HY_FAST_DECAY) / HY_DECAY_TARGET,
                          math.log(HY_SLOW_DECAY) / HY_DECAY_TARGET, HY_WIDTH, dtype=f32)
    decay = jnp.exp(-t * jnp.abs(deltas)[None, :])
    h = h * decay[:, None, None, :]
    g = jnp.concatenate([h[:, :, 0], jnp.zeros((1, HY_ORDER, HY_WIDTH), f32), h[:0:-1, :, 1]], axis=0)
    g = g / jnp.sum(jnp.abs(g), axis=0, keepdims=True)
    return jnp.fft.rfft(g, n=2 * L, axis=0)


def fft_long_conv(u, G):
    L = u.shape[1]
    U = jnp.fft.rfft(u, n=2 * L, axis=1)
    return jnp.fft.irfft(U * G[None], n=2 * L, axis=1)[:, :L]


def hyena_mixer(u_proj, conv_w, conv_b, w1, b1, w2, b2, w3, b3, sin_freq, wout, skip):
    L = u_proj.shape[1]
    u = dwconv_centred(u_proj, conv_w, conv_b).astype(jnp.float32)
    gate1, gate2, v = jnp.split(u, 3, axis=-1)
    G = hyena_filters(L, w1, b1, w2, b2, w3, b3, sin_freq, wout)
    sk = skip.astype(jnp.float32)
    z = v
    for o, gate in enumerate((gate1, gate2)):
        z = gate * (fft_long_conv(z, G[:, o]) + sk[o] * z)
    return z


def segsum(a):
    T = a.shape[-1]
    a_rep = jnp.broadcast_to(a[..., :, None], a.shape + (T,))
    strict = jnp.tril(jnp.ones((T, T), dtype=bool), -1)
    cs = jnp.cumsum(jnp.where(strict, a_rep, 0.0), axis=-2)
    return jnp.where(jnp.tril(jnp.ones((T, T), dtype=bool), 0), cs, -jnp.inf)


def ssd_chunked(xh, dt, A, Bg, Cg):
    b, L, H, P = xh.shape
    G, N = Bg.shape[-2:]
    R = H // G
    Q = SSM_CHUNK
    pad = (-L) % Q
    if pad:
        padfn = lambda a: jnp.pad(a, [(0, 0), (0, pad)] + [(0, 0)] * (a.ndim - 2))
        xh, dt, Bg, Cg = padfn(xh), padfn(dt), padfn(Bg), padfn(Cg)
    C = (L + pad) // Q
    X = (xh * dt[..., None]).reshape(b, C, Q, G, R, P)
    a = (dt * A).reshape(b, C, Q, G, R).transpose(0, 1, 3, 4, 2)
    Bc = Bg.reshape(b, C, Q, G, N)
    Cc = Cg.reshape(b, C, Q, G, N)
    a_cs = jnp.cumsum(a, axis=-1)
    Lmat = jnp.exp(segsum(a))
    CB = jnp.einsum('bclgn,bcsgn->bcgls', Cc, Bc)
    y_diag = jnp.einsum('bcgrls,bcsgrp->bclgrp', CB[:, :, :, None] * Lmat, X)
    decay_states = jnp.exp(a_cs[..., -1:] - a_cs)
    states = jnp.einsum('bcsgn,bcgrs,bcsgrp->bcgrpn', Bc, decay_states, X)
    chunk_tot = jnp.pad(a_cs[..., -1].transpose(0, 2, 3, 1), ((0, 0), (0, 0), (0, 0), (1, 0)))
    decay_chunk = jnp.exp(segsum(chunk_tot))
    states = jnp.pad(states, ((0, 0), (1, 0), (0, 0), (0, 0), (0, 0), (0, 0)))
    states_in = jnp.einsum('bgrzc,bcgrpn->bzgrpn', decay_chunk, states)[:, :-1]
    y_off = jnp.einsum('bclgn,bcgrpn,bcgrl->bclgrp', Cc, states_in, jnp.exp(a_cs))
    y = (y_diag + y_off).reshape(b, C * Q, H, P)
    return y[:, :L]


def mamba2_mixer(z, xbc, dt_raw, conv_w, conv_b, A_log, dt_bias, D, norm_g):
    f32 = jnp.float32
    xbc = jax.nn.silu(dwconv_centred(xbc, conv_w, conv_b).astype(f32))
    b, L, _ = xbc.shape
    gn = SSM_GROUPS * SSM_STATE
    xh = xbc[..., :SSM_WIDTH].reshape(b, L, SSM_HEADS, SSM_HEAD_DIM)
    Bg = xbc[..., SSM_WIDTH:SSM_WIDTH + gn].reshape(b, L, SSM_GROUPS, SSM_STATE)
    Cg = xbc[..., SSM_WIDTH + gn:].reshape(b, L, SSM_GROUPS, SSM_STATE)
    dt_raw = dt_raw.astype(f32)
    A = -jnp.exp(A_log.astype(f32))
    dtb = dt_bias.astype(f32)
    dt_f = jax.nn.softplus(dt_raw + dtb[0])
    dt_b = jax.nn.softplus(dt_raw + dtb[1])
    flip = lambda a: jnp.flip(a, axis=1)
    y_f = ssd_chunked(xh, dt_f, A[0], Bg, Cg)
    y_b = flip(ssd_chunked(flip(xh), flip(dt_b), A[1], flip(Bg), flip(Cg)))
    y = y_f + y_b + D.astype(f32)[:, None] * xh
    y = y.reshape(b, L, SSM_WIDTH) * jax.nn.silu(z.astype(f32))
    y = _rms(y.reshape(b, L, SSM_GROUPS, SSM_WIDTH // SSM_GROUPS)).reshape(b, L, SSM_WIDTH)
    return y * norm_g.astype(f32)


def setup_inputs(seed: int = 0) -> dict:
    key = jax.random.key(seed)
    ks = jax.random.split(key, 32)
    f32 = jnp.float32

    def normal(k, shape, scale):
        return jax.random.normal(k, shape, f32) * scale

    Hd = HY_FILTER_HIDDEN
    dt_init = jnp.exp(jax.random.uniform(ks[17], (DEPTH, 2, SSM_HEADS), f32,
                                         minval=math.log(1e-3), maxval=math.log(1e-1)))
    return {
        'x': normal(ks[0], (BATCH, SEQ, D_MODEL), 1.0),
        'norm_mix_g': 1.0 + normal(ks[1], (DEPTH, D_MODEL), 0.02),
        'w_in': normal(ks[2], (DEPTH, D_MODEL, N_IN), D_MODEL ** -0.5),
        'hy_conv_w': normal(ks[3], (DEPTH, SHORT_CONV, 3 * HY_WIDTH), SHORT_CONV ** -0.5),
        'hy_conv_b': normal(ks[4], (DEPTH, 3 * HY_WIDTH), 0.02),
        'hy_pos_w1': normal(ks[5], (DEPTH, HY_EMB, Hd), HY_EMB ** -0.5),
        'hy_pos_b1': normal(ks[6], (DEPTH, Hd), 0.1),
        'hy_pos_w2': normal(ks[7], (DEPTH, Hd, Hd), Hd ** -0.5),
        'hy_pos_b2': normal(ks[8], (DEPTH, Hd), 0.1),
        'hy_pos_w3': normal(ks[9], (DEPTH, Hd, Hd), Hd ** -0.5),
        'hy_pos_b3': normal(ks[10], (DEPTH, Hd), 0.1),
        'hy_sin_freq': 1.0 + normal(ks[11], (DEPTH, HY_N_SIN, Hd), 0.1),
        'hy_pos_wout': normal(ks[12], (DEPTH, Hd, HY_ORDER * 2 * HY_WIDTH), Hd ** -0.5),
        'hy_skip': normal(ks[13], (DEPTH, HY_ORDER, HY_WIDTH), 0.1),
        'hy_out_g': 1.0 + normal(ks[14], (DEPTH, HY_WIDTH), 0.02),
        'ssm_conv_w': normal(ks[15], (DEPTH, SHORT_CONV, SSM_XBC), SHORT_CONV ** -0.5),
        'ssm_conv_b': normal(ks[16], (DEPTH, SSM_XBC), 0.02),
        'ssm_A_log': jnp.log(jax.random.uniform(ks[18], (DEPTH, 2, SSM_HEADS), f32, minval=1.0, maxval=16.0)),
        'ssm_dt_bias': dt_init + jnp.log(-jnp.expm1(-dt_init)),
        'ssm_D': 1.0 + normal(ks[19], (DEPTH, SSM_HEADS), 0.1),
        'ssm_out_g': 1.0 + normal(ks[20], (DEPTH, SSM_WIDTH), 0.02),
        'w_out': normal(ks[21], (DEPTH, D_MIX, D_MODEL), D_MIX ** -0.5),
        'norm_mlp_g': 1.0 + normal(ks[22], (DEPTH, D_MODEL), 0.02),
        'w_up': normal(ks[23], (DEPTH, D_MODEL, D_FF), D_MODEL ** -0.5),
        'w_down': normal(ks[24], (DEPTH, D_FF, D_MODEL), D_FF ** -0.5),
        'final_norm_g': 1.0 + normal(ks[25], (D_MODEL,), 0.02),
    }


def reference(x, norm_mix_g, w_in, hy_conv_w, hy_conv_b, hy_pos_w1, hy_pos_b1, hy_pos_w2, hy_pos_b2,
              hy_pos_w3, hy_pos_b3, hy_sin_freq, hy_pos_wout, hy_skip, hy_out_g, ssm_conv_w, ssm_conv_b,
              ssm_A_log, ssm_dt_bias, ssm_D, ssm_out_g, w_out, norm_mlp_g, w_up, w_down, final_norm_g):
    dtype = x.dtype
    o1 = 3 * HY_WIDTH
    o2 = o1 + SSM_WIDTH
    o3 = o2 + SSM_XBC
    for l in range(DEPTH):
        h = rmsnorm(x, norm_mix_g[l])
        proj = h @ w_in[l]
        y_hy = hyena_mixer(proj[..., :o1], hy_conv_w[l], hy_conv_b[l], hy_pos_w1[l], hy_pos_b1[l],
                           hy_pos_w2[l], hy_pos_b2[l], hy_pos_w3[l], hy_pos_b3[l], hy_sin_freq[l],
                           hy_pos_wout[l], hy_skip[l])
        y_hy = _rms(y_hy) * hy_out_g[l].astype(jnp.float32)
        y_ssm = mamba2_mixer(proj[..., o1:o2], proj[..., o2:o3], proj[..., o3:], ssm_conv_w[l],
                             ssm_conv_b[l], ssm_A_log[l], ssm_dt_bias[l], ssm_D[l], ssm_out_g[l])
        mixed = jnp.concatenate([y_hy.astype(dtype), y_ssm.astype(dtype)], axis=-1) @ w_out[l]
        x = x + mixed
        h = rmsnorm(x, norm_mlp_g[l])
        x = x + jnp.square(jax.nn.relu(h @ w_up[l])) @ w_down[l]
    return rmsnorm(x, final_norm_g)
```

```cpp
#include <hip/hip_runtime.h>
#include <cstdio>
#include <cstdint>
namespace pg8 {
#define PG8_LAS __attribute__((address_space(3)))
typedef unsigned short bf16_t;
typedef short bf16x8 __attribute__((ext_vector_type(8)));
typedef float f32x4 __attribute__((ext_vector_type(4)));
typedef unsigned u32x4 __attribute__((ext_vector_type(4)));
constexpr int BM = 256, BK = 64, HALF = 128, HTB = HALF * BK * 2  , STAGE_BYTES = 8 * HTB, NXCD = 8, WGM = 8;

__host__ __device__ __forceinline__ int lds_byte(int r, int c) { const int st = (r >> 4) * 2 + (c >> 5), rr = r & 15, cc = c & 31, ob = rr * 64 + cc * 2; return st * 1024 + (ob ^ (((ob >> 9) & 1) << 5)); }
__host__ __device__ __forceinline__ void stage_rc(int b, int& R, int& C) { const int st = b / 1024, sb = b % 1024, swz = sb ^ (((sb >> 9) & 1) << 5); R = (st >> 1) * 16 + swz / 64; C = (st & 1) * 32 + (swz % 64) / 2; }
__host__ __device__ __forceinline__ int perm32(int rho) { const int n = rho >> 4, i = rho & 15; return 8 * (i >> 2) + 4 * n + (i & 3); }

struct Unit { int pm, pn; };
struct Gemm { const bf16_t* A; const bf16_t* Bt; int M, N, K; };

struct StaticOrder {
    int nM, nN, nwg, G, c;
    __host__ __device__ void init(int M, int N, int G_, int c_) { nM = M / BM; nN = N / BM; nwg = nM * nN; G = G_; c = c_; }
    __host__ __device__ bool next(int i, Unit& u) const {
        const long L = (long)i * G + c; if (L >= nwg) return false;
        int wgid = (int)L; { const int q = nwg / NXCD, r = nwg % NXCD, xcd = wgid % NXCD, off = wgid / NXCD; wgid = (xcd < r ? xcd * (q + 1) : r * (q + 1) + (xcd - r) * q) + off; }
        const int nig = WGM * nN, gid = wgid / nig, fm = gid * WGM, gsz = (nM - fm) < WGM ? (nM - fm) : WGM;
        u.pm = fm + ((wgid % nig) % gsz); u.pn = (wgid % nig) / gsz; return true;
    }
    __device__ __forceinline__ void a_ready(const Unit&) const {}
    __device__ __forceinline__ void done(const Unit&) const {}
};

__device__ __forceinline__ unsigned cvt_pk_bf16(float lo, float hi) { unsigned r; asm volatile("v_cvt_pk_bf16_f32 %0, %1, %2" : "=v"(r) : "v"(lo), "v"(hi)); return r; }
__device__ __forceinline__ float rstd_of(float ssq) { return 1.0f / sqrtf(ssq * (1.0f / 4096.0f) + 1e-5f); }
template <int ACT, int MODE> struct EpiBf16P {
    static constexpr bool PERM = true, AFTER_DRAIN = false;
    bf16_t* O; int ldc; const float* rstd;
    __device__ __forceinline__ void operator()(const f32x4 (&acc)[2][2][4][2], const Unit& u, int wr, int wc, int fr, int fq) const {
        const int row0 = u.pm * BM + wr * 64 + fr, col0 = u.pn * BM + wc * 32 + 8 * fq;
        f32x4 cs[2][2];
        if (MODE == 2) {
#pragma unroll
            for (int bj = 0; bj < 2; ++bj)
#pragma unroll
                for (int n = 0; n < 2; ++n) cs[bj][n] = *(const f32x4*)(rstd + col0 + bj * HALF + 4 * n);
        }
#pragma unroll
        for (int ai = 0; ai < 2; ++ai)
#pragma unroll
            for (int m = 0; m < 4; ++m) { const int row = row0 + ai * HALF + m * 16; bf16_t* rowp = O + (size_t)row * ldc + col0;
                float rs = 1.f; if (MODE == 1) rs = rstd[row];
#pragma unroll
                for (int bj = 0; bj < 2; ++bj) { f32x4 v0 = acc[ai][bj][m][0], v1 = acc[ai][bj][m][1];
                    if (MODE == 1) { v0 = v0 * rs; v1 = v1 * rs; }
                    if (MODE == 2) { v0 = v0 * cs[bj][0]; v1 = v1 * cs[bj][1]; }
                    if (ACT == 1) {
#pragma unroll
                        for (int j = 0; j < 4; ++j) { const float a = fmaxf(v0[j], 0.f), b = fmaxf(v1[j], 0.f); v0[j] = a * a; v1[j] = b * b; } }
                    u32x4 w; w.x = cvt_pk_bf16(v0[0], v0[1]); w.y = cvt_pk_bf16(v0[2], v0[3]); w.z = cvt_pk_bf16(v1[0], v1[1]); w.w = cvt_pk_bf16(v1[2], v1[3]);
                    *(u32x4*)(rowp + bj * HALF) = w; } }
    }
};
struct EpiRes {
    static constexpr bool PERM = false, AFTER_DRAIN = false;
    const float* base; float* out; bf16_t* xb; float* part; int ldc, nrows;
    __device__ __forceinline__ void operator()(const f32x4 (&acc)[2][2][4][2], const Unit& u, int wr, int wc, int fr, int fq) const {
        typedef unsigned u32x2 __attribute__((ext_vector_type(2)));
        const int row0 = u.pm * BM + wr * 64 + fr, col0 = u.pn * BM + wc * 32 + 4 * fq;
#pragma unroll
        for (int ai = 0; ai < 2; ++ai)
#pragma unroll
            for (int m = 0; m < 4; ++m) { const int row = row0 + ai * HALF + m * 16; const size_t off = (size_t)row * ldc + col0;
                float sq = 0.f;
#pragma unroll
                for (int bj = 0; bj < 2; ++bj)
#pragma unroll
                    for (int n = 0; n < 2; ++n) { const f32x4 bs = *(const f32x4*)(base + off + bj * HALF + n * 16); const f32x4 o = bs + acc[ai][bj][m][n];
                        *(f32x4*)(out + off + bj * HALF + n * 16) = o;
                        u32x2 w; w.x = cvt_pk_bf16(o[0], o[1]); w.y = cvt_pk_bf16(o[2], o[3]); *(u32x2*)(xb + off + bj * HALF + n * 16) = w;
                        sq += (o[0] * o[0] + o[1] * o[1]) + (o[2] * o[2] + o[3] * o[3]); }
                sq += __shfl_xor(sq, 16); sq += __shfl_xor(sq, 32);
                if (fq == 0) part[(size_t)(4 * u.pn + wc) * nrows + row] = sq;
                if ((m & 1) == 1) asm volatile("" ::: "memory"); }
    }
};

template <class Epi, class Sched, bool ALIGN_EPI = false, bool SP2 = false>
__device__ __forceinline__ void gemm_phase(PG8_LAS unsigned char* lds, const Gemm g, const Sched& S, const Epi& E, int tid_arg) {
    int tid_ = tid_arg; asm volatile("" : "+v"(tid_));
    const int tid = tid_, wid = __builtin_amdgcn_readfirstlane(tid >> 6), lane = tid & 63, wr = wid >> 2, wc = wid & 3, fr = lane & 15, fq = lane >> 4;
    const int K = g.K, nt = K / BK;
    unsigned voffA[2], voffB[2];
#pragma unroll
    for (int i = 0; i < 2; ++i) { int R, C; stage_rc(tid * 16 + i * 8192, R, C); const int Rb = Epi::PERM ? ((R & ~31) + perm32(R & 31)) : R;
        voffA[i] = (unsigned)(R * K + C) * 2u; voffB[i] = (unsigned)(Rb * K + C) * 2u; }
    const size_t kstep = (size_t)(BK * 2);
    const size_t hstep = (size_t)HALF * K * 2;
    const size_t tstep = 2 * hstep;
    const unsigned ldsw = (unsigned)wid * 1024u;
    const int aoff = lds_byte(wr * 64 + fr, fq * 8), boff = lds_byte(wc * 32 + fr, fq * 8);
#define PG8_SA(b, h) (((b) * 2 + (h)) * HTB)
#define PG8_SB(b, h) ((4 + (b) * 2 + (h)) * HTB)
#define PG8_STAGE(bufoff, gbase, voff) do { _Pragma("unroll") for (int _i = 0; _i < 2; ++_i) \
        __builtin_amdgcn_global_load_lds((const unsigned*)((const char*)(gbase) + (voff)[_i]), (PG8_LAS unsigned*)(lds + (bufoff) + ldsw + _i * 8192), 16, 0, 0); } while (0)
#define PG8_LDA(dst, b, h) do { _Pragma("unroll") for (int m = 0; m < 4; ++m) _Pragma("unroll") for (int k = 0; k < 2; ++k) dst[m][k] = *(const PG8_LAS bf16x8*)(lds + PG8_SA(b, h) + aoff + m * 2048 + k * 1024); } while (0)
#define PG8_LDB(dst, b, h) do { _Pragma("unroll") for (int n = 0; n < 2; ++n) _Pragma("unroll") for (int k = 0; k < 2; ++k) dst[n][k] = *(const PG8_LAS bf16x8*)(lds + PG8_SB(b, h) + boff + n * 2048 + k * 1024); } while (0)
#define PG8_MMA(ai, bj, At, Bt) do { __builtin_amdgcn_s_setprio(1); _Pragma("unroll") for (int m = 0; m < 4; ++m) _Pragma("unroll") for (int n = 0; n < 2; ++n) _Pragma("unroll") for (int k = 0; k < 2; ++k) \
        acc[ai][bj][m][n] = __builtin_amdgcn_mfma_f32_16x16x32_bf16(Bt[n][k], At[m][k], acc[ai][bj][m][n], 0, 0, 0); __builtin_amdgcn_s_setprio(0); } while (0)
#define PG8_WAIT_V(n) asm volatile("s_waitcnt vmcnt(" #n ")" ::: "memory")
#define PG8_WAIT_L(n) asm volatile("s_waitcnt lgkmcnt(" #n ")" ::: "memory")
#define PG8_BAR __builtin_amdgcn_s_barrier()
#define PG8_SCHED __builtin_amdgcn_sched_barrier(0)
    Unit cur, nxt; int ui = 0;
    if (!S.next(0, cur)) return;
    f32x4 acc[2][2][4][2];
#pragma unroll
    for (int a = 0; a < 2; ++a)
#pragma unroll
        for (int b = 0; b < 2; ++b)
#pragma unroll
            for (int m = 0; m < 4; ++m)
#pragma unroll
                for (int n = 0; n < 2; ++n) acc[a][b][m][n] = (f32x4){0.f, 0.f, 0.f, 0.f};
    bf16x8 At[4][2], B0[2][2], B1[2][2];
    const char* cA = (const char*)g.A + (size_t)cur.pm * tstep; const char* cB = (const char*)g.Bt + (size_t)cur.pn * tstep;
    S.a_ready(cur);
    if constexpr (SP2) {
        PG8_STAGE(PG8_SB(0, 0), cB, voffB); PG8_STAGE(PG8_SB(0, 1), cB + hstep, voffB); PG8_STAGE(PG8_SA(0, 0), cA, voffA); PG8_STAGE(PG8_SA(0, 1), cA + hstep, voffA);
        if (wr == 1) PG8_BAR;
        PG8_WAIT_V(2); PG8_BAR;
        PG8_STAGE(PG8_SB(1, 0), cB + kstep, voffB); PG8_STAGE(PG8_SA(1, 0), cA + kstep, voffA); PG8_STAGE(PG8_SB(1, 1), cB + hstep + kstep, voffB);
        PG8_WAIT_V(6); PG8_BAR;
    } else {
        PG8_STAGE(PG8_SB(0, 0), cB, voffB); PG8_STAGE(PG8_SA(0, 0), cA, voffA); PG8_STAGE(PG8_SB(0, 1), cB + hstep, voffB); PG8_STAGE(PG8_SA(0, 1), cA + hstep, voffA);
        if (wr == 1) PG8_BAR;
        PG8_WAIT_V(4); PG8_BAR;
        PG8_STAGE(PG8_SB(1, 0), cB + kstep, voffB); PG8_STAGE(PG8_SA(1, 0), cA + kstep, voffA); PG8_STAGE(PG8_SB(1, 1), cB + hstep + kstep, voffB);
        PG8_WAIT_V(6); PG8_BAR;
    }
    for (;;) {
        const bool has_next = S.next(ui + 1, nxt);
        const char* nA = has_next ? (const char*)g.A + (size_t)nxt.pm * tstep : cA; const char* nB = has_next ? (const char*)g.Bt + (size_t)nxt.pn * tstep : cB;
        for (int t = 0; t < nt; t += 2) {
            const bool last = (t == nt - 2);
            const char* a1 = cA + (size_t)(t + 1) * kstep;
            const char* a2 = last ? nA : cA + (size_t)(t + 2) * kstep; const char* b2 = last ? nB : cB + (size_t)(t + 2) * kstep;
            const char* a3 = a2 + kstep; const char* b3 = b2 + kstep;
            if (last && has_next) S.a_ready(nxt);
            if constexpr (SP2) {
            PG8_LDB(B0, 0, 0); PG8_LDB(B1, 0, 1); PG8_SCHED; PG8_LDA(At, 0, 0); PG8_STAGE(PG8_SA(1, 1), a1 + hstep, voffA);
            PG8_WAIT_V(8); PG8_WAIT_L(0); PG8_BAR; PG8_MMA(0, 0, At, B0); PG8_MMA(0, 1, At, B1); PG8_BAR; PG8_SCHED;
            PG8_LDA(At, 0, 1); PG8_STAGE(PG8_SB(0, 0), b2, voffB); PG8_STAGE(PG8_SB(0, 1), b2 + hstep, voffB); PG8_STAGE(PG8_SA(0, 0), a2, voffA);
            PG8_WAIT_V(8); PG8_WAIT_L(0); PG8_BAR; PG8_MMA(1, 0, At, B0); PG8_MMA(1, 1, At, B1); PG8_BAR; PG8_SCHED;
            PG8_LDB(B0, 1, 0); PG8_LDB(B1, 1, 1); PG8_SCHED; PG8_LDA(At, 1, 0); PG8_STAGE(PG8_SA(0, 1), a2 + hstep, voffA);
            PG8_WAIT_V(8); PG8_WAIT_L(0); PG8_BAR; PG8_MMA(0, 0, At, B0); PG8_MMA(0, 1, At, B1); PG8_BAR; PG8_SCHED;
            PG8_LDA(At, 1, 1); PG8_STAGE(PG8_SB(1, 0), b3, voffB); PG8_STAGE(PG8_SB(1, 1), b3 + hstep, voffB); PG8_STAGE(PG8_SA(1, 0), a3, voffA);
            PG8_WAIT_V(8); PG8_WAIT_L(0); PG8_BAR; PG8_MMA(1, 0, At, B0); PG8_MMA(1, 1, At, B1); PG8_BAR; PG8_SCHED;
            } else {
            PG8_LDB(B0, 0, 0); PG8_SCHED; PG8_LDA(At, 0, 0); PG8_STAGE(PG8_SA(1, 1), a1 + hstep, voffA);
            PG8_WAIT_L(8); PG8_BAR; PG8_WAIT_L(0); PG8_MMA(0, 0, At, B0); PG8_BAR; PG8_SCHED;
            PG8_LDB(B1, 0, 1); PG8_STAGE(PG8_SB(0, 0), b2, voffB);
            PG8_BAR; PG8_WAIT_L(0); PG8_MMA(0, 1, At, B1); PG8_BAR;
            PG8_LDA(At, 0, 1); PG8_STAGE(PG8_SA(0, 0), a2, voffA);
            PG8_BAR; PG8_WAIT_L(0); PG8_MMA(1, 0, At, B0); PG8_BAR; PG8_SCHED;
            PG8_STAGE(PG8_SB(0, 1), b2 + hstep, voffB);
            PG8_WAIT_V(6); PG8_BAR; PG8_MMA(1, 1, At, B1); PG8_BAR;
            PG8_LDB(B0, 1, 0); PG8_SCHED; PG8_LDA(At, 1, 0); PG8_STAGE(PG8_SA(0, 1), a2 + hstep, voffA);
            PG8_WAIT_L(8); PG8_BAR; PG8_WAIT_L(0); PG8_MMA(0, 0, At, B0); PG8_BAR; PG8_SCHED;
            PG8_LDB(B1, 1, 1); PG8_STAGE(PG8_SB(1, 0), b3, voffB);
            PG8_BAR; PG8_WAIT_L(0); PG8_MMA(0, 1, At, B1); PG8_BAR;
            PG8_LDA(At, 1, 1); PG8_STAGE(PG8_SA(1, 0), a3, voffA);
            PG8_BAR; PG8_WAIT_L(0); PG8_MMA(1, 0, At, B0); PG8_BAR; PG8_SCHED;
            PG8_STAGE(PG8_SB(1, 1), b3 + hstep, voffB);
            PG8_WAIT_V(6); PG8_BAR; PG8_MMA(1, 1, At, B1); PG8_BAR;
            }
        }
        if constexpr (ALIGN_EPI) { if (wr == 0) PG8_BAR; }
        if constexpr (!Epi::AFTER_DRAIN) { E(acc, cur, wr, wc, fr, fq); S.done(cur); }
        if (!has_next) break;
#pragma unroll
        for (int a = 0; a < 2; ++a)
#pragma unroll
            for (int b = 0; b < 2; ++b)
#pragma unroll
                for (int m = 0; m < 4; ++m)
#pragma unroll
                    for (int n = 0; n < 2; ++n) acc[a][b][m][n] = (f32x4){0.f, 0.f, 0.f, 0.f};
        cur = nxt; cA = nA; cB = nB; ++ui;
        if constexpr (ALIGN_EPI) { if (wr == 1) PG8_BAR; }
    }
    PG8_WAIT_V(0);
    if constexpr (!ALIGN_EPI) { if (wr == 0) PG8_BAR; }
    PG8_BAR;
    if constexpr (Epi::AFTER_DRAIN) { E.fused(acc, cur, wr, wc, fr, fq, lds, wid, lane); S.done(cur); }
#undef PG8_SA
#undef PG8_SB
#undef PG8_STAGE
#undef PG8_LDA
#undef PG8_LDB
#undef PG8_MMA
#undef PG8_WAIT_V
#undef PG8_WAIT_L
#undef PG8_BAR
#undef PG8_SCHED
}
}

constexpr int SEQ = 16384, DM = 4096, DEPTH = 4, HYW = 2048, SSW = 2048, NHEAD = 32, HDIM = 64, NGRP = 8, NST = 128, QCH = 256, NCH = SEQ / QCH;
constexpr int NIN = 12320, DFF = 16384, XBCW = 4096, PSW = 6144, NTAP = 8192;
constexpr float EPS = 1e-5f;
enum { I_X = 0, I_NMG, I_WIN, I_HCW, I_HCB, I_PW1, I_PB1, I_PW2, I_PB2, I_PW3, I_PB3, I_SF, I_WOUTF, I_SKIP, I_HOG, I_SCW, I_SCB, I_ALOG, I_DTB, I_SD, I_SOG, I_WO, I_NLG, I_WUP, I_WDN, I_FNG, N_INPUTS };

constexpr size_t MiB = 1u << 20;
constexpr size_t WS_CTL = 0, CTL_ZERO_BYTES = 1 * MiB;
constexpr size_t WS_TW = 1 * MiB;
constexpr size_t WS_PW = WS_TW + 131072;
constexpr size_t WS_WIN = 2 * MiB;
constexpr size_t WS_WOUT = 100 * MiB;
constexpr size_t WS_WUP = 132 * MiB;
constexpr size_t WS_WDN = 260 * MiB;
constexpr size_t WS_XN = 388 * MiB;
constexpr size_t WS_PT = 516 * MiB;
constexpr size_t WS_PS = 708 * MiB;
constexpr size_t WS_XBC = 900 * MiB;
constexpr size_t WS_H3 = 1028 * MiB;
constexpr size_t WS_DTF = 1032 * MiB, WS_DTB = 1034 * MiB, WS_ACS = 1036 * MiB, WS_RB = 1038 * MiB, WS_SSQ = 1040 * MiB, WS_DTRAW = 1042 * MiB;
constexpr size_t WS_SSQA = 1028 * MiB + 2 * MiB, WS_SSQB = WS_SSQA + 65536;
constexpr size_t WS_PARTA = 2900 * MiB, WS_PARTB = 2904 * MiB;
constexpr size_t WS_HT = 1044 * MiB;
constexpr size_t WS_Z2T = 1556 * MiB;
constexpr size_t WS_S = 1684 * MiB;
constexpr size_t WS_SIN = 1812 * MiB;
constexpr size_t WS_YMIX = 1876 * MiB;
constexpr size_t WS_X = 2004 * MiB;
constexpr size_t WS_H = 2260 * MiB;
constexpr size_t WS_GSCR = 2772 * MiB;
constexpr size_t GSCR_PER_WG = 17 * 512 * 16 + 16 * 512 * 8;
constexpr size_t WS_END = 2908 * MiB;
constexpr int CW_BAR = 4096;

constexpr int LDS_BYTES = 163840;
constexpr int MISC_OFF = LDS_BYTES - 256;
constexpr int FFT_BYTES = (16384 + 512) * 8;
constexpr int RED_OFF = FFT_BYTES;

#define GAS __attribute__((address_space(1)))
#define LAS __attribute__((address_space(3)))
typedef unsigned short bf16;
typedef unsigned v4u __attribute__((ext_vector_type(4)));
typedef unsigned v2u __attribute__((ext_vector_type(2)));
typedef float f32x4 __attribute__((ext_vector_type(4)));
typedef float f32x2 __attribute__((ext_vector_type(2)));
typedef float f32x16 __attribute__((ext_vector_type(16)));
typedef short bf16x8 __attribute__((ext_vector_type(8)));
typedef short bf16x4 __attribute__((ext_vector_type(4)));
#define LDS_WAIT() asm volatile("s_waitcnt lgkmcnt(0)" ::: "memory")
__device__ __forceinline__ float bf2f(unsigned short h) { return __uint_as_float((unsigned)h << 16); }
__device__ __forceinline__ float bflo(unsigned w) { return __uint_as_float(w << 16); }
__device__ __forceinline__ float bfhi(unsigned w) { return __uint_as_float(w & 0xffff0000u); }
__device__ __forceinline__ unsigned pk2(float lo, float hi) { return pg8::cvt_pk_bf16(lo, hi); }
__device__ __forceinline__ float wave_sum(float v) {
#pragma unroll
    for (int o = 1; o < 64; o <<= 1) v += __shfl_xor(v, o);
    return v;
}
__device__ __forceinline__ float rdlane(float v, int l) { return __int_as_float(__builtin_amdgcn_readlane(__float_as_int(v), l)); }
__device__ __forceinline__ float silu_f(float x) { return x / (1.0f + __expf(-x)); }
__device__ __forceinline__ float softplus_f(float x) { return fmaxf(x, 0.f) + log1pf(expf(-fabsf(x))); }

#define XB_TMO      128
#define XB_XCNT(j)  (256  + 64 * (j))
#define XB_XSUB(j)  (1280 + 64 * (j))
#define XB_XGEN(j)  (2304 + 64 * (j))
#define XB_TOP      3328
#define XB_TOPGEN   3392
#define XCD_BAR_WORDS 3456
#define XB_SPIN_CAP (1u << 18)

__device__ __forceinline__ unsigned xb_ld(unsigned* p)              { return __hip_atomic_load(p, __ATOMIC_RELAXED, __HIP_MEMORY_SCOPE_AGENT); }
__device__ __forceinline__ unsigned xb_add(unsigned* p, unsigned v) { return __hip_atomic_fetch_add(p, v, __ATOMIC_RELAXED, __HIP_MEMORY_SCOPE_AGENT); }
__device__ __forceinline__ unsigned xb_xcc_id() { return (unsigned)__builtin_amdgcn_s_getreg((3 << 11) | 20) & 0xFu; }
#define XB_SPIN(cond, bar) do { unsigned _sp = 0; while (cond) { __builtin_amdgcn_s_sleep(1); \
    if ((++_sp & 255u) == 0u) { if (xb_ld(&(bar)[XB_TMO])) break; if (_sp > XB_SPIN_CAP) { atomicAdd(&(bar)[XB_TMO], 1u); break; } } } } while (0)

struct XcdBarrier {
    unsigned* bar; unsigned x;
    volatile LAS unsigned* st;
};

__device__ __forceinline__ XcdBarrier xcd_barrier_post(unsigned* bar, volatile LAS unsigned* st) {
    XcdBarrier b; b.bar = bar; b.x = xb_xcc_id(); b.st = st;
    if (threadIdx.x == 0) (void)xb_add(&bar[XB_XCNT(b.x)], 1u);
    return b;
}
__device__ __forceinline__ void xcd_barrier_complete(unsigned* bar, unsigned x, unsigned& nloc, unsigned& nx) {
    const unsigned G = gridDim.x * gridDim.y * gridDim.z;
    unsigned sum, cnt, mine, sp = 0u;
    for (;;) {
        sum = 0u; cnt = 0u; mine = 0u;
#pragma unroll
        for (unsigned j = 0; j < 16; ++j) { const unsigned c = xb_ld(&bar[XB_XCNT(j)]); sum += c; cnt += (c > 0u) ? 1u : 0u; mine = (j == x) ? c : mine; }
        if (sum == G) break;
        __builtin_amdgcn_s_sleep(1);
        if ((++sp & 255u) == 0u) { if (xb_ld(&bar[XB_TMO])) break; if (sp > XB_SPIN_CAP) { atomicAdd(&bar[XB_TMO], 1u); break; } }
    }
    nloc = mine > 0u ? mine : 1u; nx = cnt > 0u ? cnt : 1u;
}

__device__ __forceinline__ void xcd_barrier(const XcdBarrier& b) {
    asm volatile("s_waitcnt vmcnt(0)" ::: "memory");
    __syncthreads();
    if (threadIdx.x == 0) {
        unsigned* bar = b.bar;
        __builtin_amdgcn_s_waitcnt(0);
        unsigned nloc = b.st[0], nx = b.st[1];
        if (nloc == 0u) { xcd_barrier_complete(bar, b.x, nloc, nx); b.st[0] = nloc; b.st[1] = nx; }
        const unsigned old = xb_add(&bar[XB_XSUB(b.x)], 1u);
        const unsigned gen = old / nloc;
        if (old + 1u == (gen + 1u) * nloc) {
            __builtin_amdgcn_fence(__ATOMIC_RELEASE, "agent");
            asm volatile("s_waitcnt vmcnt(0)" ::: "memory");
            const unsigned og = xb_add(&bar[XB_TOP], 1u);
            const unsigned tg = og / nx;
            if (og + 1u == (tg + 1u) * nx) xb_add(&bar[XB_TOPGEN], 1u);
            else XB_SPIN(xb_ld(&bar[XB_TOPGEN]) == tg, bar);
            __builtin_amdgcn_fence(__ATOMIC_ACQUIRE, "agent");
            xb_add(&bar[XB_XGEN(b.x)], 1u);
            asm volatile("s_waitcnt vmcnt(0)" ::: "memory");
        } else {
            XB_SPIN(xb_ld(&bar[XB_XGEN(b.x)]) == gen, bar);
            __builtin_amdgcn_fence(__ATOMIC_ACQUIRE, "agent");
            asm volatile("s_waitcnt vmcnt(0)" ::: "memory");
        }
    }
    __syncthreads();
}

__device__ __forceinline__ void transpose_item(const float* W, int K, int N, bf16* WT, LAS float* scr, int item, int lane, const float* gk) {
    const int nblk = N / 32, kb = item / nblk, nb = item % nblk, k0 = 64 * kb, n0 = 32 * nb;
#pragma unroll 8
    for (int i = 0; i < 32; ++i) { const int kk = 2 * i + (lane >> 5); scr[kk * 33 + (lane & 31)] = W[(size_t)(k0 + kk) * N + n0 + (lane & 31)]; }
    LDS_WAIT(); asm volatile("" ::: "memory");
    const int c = lane & 7;
    f32x4 g0 = (f32x4){1.f, 1.f, 1.f, 1.f}, g1 = g0;
    if (gk) { g0 = *(const f32x4*)(gk + k0 + 8 * c); g1 = *(const f32x4*)(gk + k0 + 8 * c + 4); }
#pragma unroll
    for (int j = 0; j < 4; ++j) { const int n = (lane >> 3) + 8 * j; const LAS float* s = scr + (8 * c) * 33 + n;
        v4u o; o.x = pk2(s[0 * 33] * g0.x, s[1 * 33] * g0.y); o.y = pk2(s[2 * 33] * g0.z, s[3 * 33] * g0.w); o.z = pk2(s[4 * 33] * g1.x, s[5 * 33] * g1.y); o.w = pk2(s[6 * 33] * g1.z, s[7 * 33] * g1.w);
        *(v4u*)(WT + (size_t)(n0 + n) * K + k0 + 8 * c) = o; }
    LDS_WAIT(); asm volatile("" ::: "memory");
}
template <bool TO_BF16>
__device__ __forceinline__ void rms_row(const float* xrow, const float* g, void* orow, int lane) {
    const f32x4* xr = (const f32x4*)xrow + lane;
    f32x4 v[16]; float s = 0.f;
#pragma unroll
    for (int j = 0; j < 16; ++j) { v[j] = xr[64 * j]; s += (v[j].x * v[j].x + v[j].y * v[j].y) + (v[j].z * v[j].z + v[j].w * v[j].w); }
    const float r = 1.0f / sqrtf(wave_sum(s) * (1.f / DM) + EPS);
    const f32x4* gr = (const f32x4*)g + lane;
#pragma unroll
    for (int j = 0; j < 16; ++j) { const f32x4 gg = gr[64 * j]; const f32x4 o = v[j] * r * gg;
        if (TO_BF16) { v2u w; w.x = pk2(o.x, o.y); w.y = pk2(o.z, o.w); ((v2u*)orow)[lane + 64 * j] = w; }
        else ((f32x4*)orow)[lane + 64 * j] = o; }
}
__device__ __forceinline__ void rstd_reduce(const float* part, float* rstd, int row) {
    float s = 0.f;
#pragma unroll 16
    for (int j = 0; j < 64; ++j) s += part[(size_t)j * SEQ + row];
    rstd[row] = pg8::rstd_of(s);
}
__device__ __forceinline__ void prep_row(const float* xrow, bf16* orow, float* rstd, int lane) {
    const f32x4* xr = (const f32x4*)xrow + lane; float s = 0.f;
#pragma unroll
    for (int j = 0; j < 16; ++j) { const f32x4 v = xr[64 * j]; s += (v.x * v.x + v.y * v.y) + (v.z * v.z + v.w * v.w); v2u w; w.x = pk2(v.x, v.y); w.y = pk2(v.z, v.w); ((v2u*)orow)[lane + 64 * j] = w; }
    s = wave_sum(s);
    if (lane == 0) *rstd = pg8::rstd_of(s);
}
__device__ __forceinline__ void posmlp_row(int t, const float* w1, const float* b1, const float* w2, const float* b2, const float* w3, const float* b3, const float* sf, bf16* h3row, int lane) {
    const float tl = (float)t / 16383.0f;
    const float wang = (6.283185307179586f * (float)t) / 16384.0f;
    float zf = 0.f;
    if (lane == 0) zf = tl;
    else if (lane <= 32) { const int i = (lane - 1) & 15; const float sfr = (float)i / 15.0f; const float f = 1e-4f * (1.0f - sfr) + 15.0f * sfr; const float ang = f * wang; zf = (lane <= 16) ? cosf(ang) : -sinf(ang); }
    float acc = b1[lane];
#pragma unroll 11
    for (int f = 0; f < 33; ++f) acc += rdlane(zf, f) * w1[f * 64 + lane];
    float h = sinf(sf[lane] * acc);
    acc = b2[lane];
#pragma unroll 8
    for (int i = 0; i < 64; ++i) acc += rdlane(h, i) * w2[i * 64 + lane];
    h = sinf(sf[64 + lane] * acc);
    acc = b3[lane];
#pragma unroll 8
    for (int i = 0; i < 64; ++i) acc += rdlane(h, i) * w3[i * 64 + lane];
    h = sinf(sf[128 + lane] * acc);
    h3row[lane] = (bf16)(pk2(h, h) & 0xffffu);
}
__device__ __forceinline__ f32x4 mfma16_t(bf16x8 a, bf16x8 b, f32x4 c) { return __builtin_amdgcn_mfma_f32_16x16x32_bf16(a, b, c, 0, 0, 0); }
__device__ __forceinline__ void taps_gemm(const float* wout, const bf16* h3, bf16* HT, int gw, int NGW, int lane) {
    const int g = lane >> 4, li = lane & 15;
    const int ngroups = NGW / 256;
    if (ngroups == 0) return;
    const int nblk = gw % 256, tg = gw / 256;
    if (tg >= ngroups) return;
    const int n0 = 32 * nblk, steps_per = (SEQ / 16) / ngroups;
    const bool bwd = ((n0 >> 11) & 1) != 0;
    bf16x8 wf[2][2];
#pragma unroll
    for (int nt = 0; nt < 2; ++nt)
#pragma unroll
        for (int ks = 0; ks < 2; ++ks) { float w[8];
#pragma unroll
            for (int j = 0; j < 8; ++j) w[j] = wout[(size_t)(32 * ks + 8 * g + j) * NTAP + n0 + 16 * nt + li];
            v4u p; p.x = pk2(w[0], w[1]); p.y = pk2(w[2], w[3]); p.z = pk2(w[4], w[5]); p.w = pk2(w[6], w[7]); wf[nt][ks] = __builtin_bit_cast(bf16x8, p); }
    float ad[2];
#pragma unroll
    for (int nt = 0; nt < 2; ++nt) { const int c = (n0 + 16 * nt + li) & 2047; const float sfr = (float)c / 2047.0f;
        ad[nt] = fabsf(-120.39728043259361f * (1.0f - sfr) + 40.546510810816436f * sfr); }
    const int off = bwd ? 1 : 0;
#pragma unroll 2
    for (int i = 0; i < steps_per; ++i) {
        const int t0 = 16 * (tg * steps_per + i);
        const int trow = t0 + li + off;
        bf16x8 a0 = (bf16x8){0, 0, 0, 0, 0, 0, 0, 0}, a1 = a0;
        if (trow < SEQ) { const bf16x8* hr = (const bf16x8*)(h3 + (size_t)trow * 64 + 8 * g); a0 = hr[0]; a1 = hr[4]; }
        const float tl0 = (float)(t0 + off + 4 * g) / 16383.0f;
#pragma unroll
        for (int nt = 0; nt < 2; ++nt) {
            f32x4 d = (f32x4){0.f, 0.f, 0.f, 0.f};
            d = mfma16_t(a0, wf[nt][0], d); d = mfma16_t(a1, wf[nt][1], d);
            float v[4];
#pragma unroll
            for (int r = 0; r < 4; ++r) v[r] = d[r] * __expf(-(tl0 + (float)r / 16383.0f) * ad[nt]);
            bf16* rowp = HT + (size_t)(n0 + 16 * nt + li) * SEQ;
            v2u o;
            if (!bwd) { o.x = pk2(v[0], v[1]); o.y = pk2(v[2], v[3]); *(v2u*)(rowp + t0 + 4 * g) = o; }
            else { if (t0 + 4 * g + 4 == SEQ) v[3] = 0.f;
                   o.x = pk2(v[3], v[2]); o.y = pk2(v[1], v[0]); *(v2u*)(rowp + (SEQ - t0 - 4 * g - 4)) = o; }
        }
    }
}

#define CMULV(xr, xi, br, bi) do { const float _t = (xr) * (br) - (xi) * (bi); (xi) = (xr) * (bi) + (xi) * (br); (xr) = _t; } while (0)
#define DFT4V(r0, i0, r1, i1, r2, i2, r3, i3) do { \
    const f32x2 t0r = (r0) + (r2), t0i = (i0) + (i2), t1r = (r0) - (r2), t1i = (i0) - (i2); \
    const f32x2 t2r = (r1) + (r3), t2i = (i1) + (i3), dr = (r1) - (r3), di = (i1) - (i3); \
    (r0) = t0r + t2r; (i0) = t0i + t2i; (r2) = t0r - t2r; (i2) = t0i - t2i; \
    (r1) = t1r + di; (i1) = t1i - dr; (r3) = t1r - di; (i3) = t1i + dr; } while (0)
#define CMULVV(xr, xi, br, bi) do { const f32x2 _t = (xr) * (br) - (xi) * (bi); (xi) = (xr) * (bi) + (xi) * (br); (xr) = _t; } while (0)
__device__ __forceinline__ void dft16(f32x2 (&ar)[16], f32x2 (&ai)[16]) {
    const float C1 = 0.92387953251128674f, S1 = 0.38268343236508977f, HH = 0.70710678118654752f;
#pragma unroll
    for (int n2 = 0; n2 < 4; ++n2) DFT4V(ar[n2], ai[n2], ar[4 + n2], ai[4 + n2], ar[8 + n2], ai[8 + n2], ar[12 + n2], ai[12 + n2]);
    CMULVV(ar[5], ai[5], C1, -S1);
    CMULVV(ar[9], ai[9], HH, -HH);
    CMULVV(ar[13], ai[13], S1, -C1);
    CMULVV(ar[6], ai[6], HH, -HH);
    { const f32x2 t = ar[10]; ar[10] = ai[10]; ai[10] = -t; }
    CMULVV(ar[14], ai[14], -HH, -HH);
    CMULVV(ar[7], ai[7], S1, -C1);
    CMULVV(ar[11], ai[11], -HH, -HH);
    CMULVV(ar[15], ai[15], -C1, S1);
#pragma unroll
    for (int k1 = 0; k1 < 4; ++k1) DFT4V(ar[4 * k1], ai[4 * k1], ar[4 * k1 + 1], ai[4 * k1 + 1], ar[4 * k1 + 2], ai[4 * k1 + 2], ar[4 * k1 + 3], ai[4 * k1 + 3]);
}
#define CMULT(xr, xi, br, bi) do { const auto _t = (xr) * (br) - (xi) * (bi); (xi) = (xr) * (bi) + (xi) * (br); (xr) = _t; } while (0)
template <class T>
__device__ __forceinline__ void twiddle16(f32x2 (&ar)[16], f32x2 (&ai)[16], T wr, T wi) {
    const T w2r = wr * wr - wi * wi, w2i = 2.f * wr * wi;
    const T w3r = w2r * wr - w2i * wi, w3i = w2r * wi + w2i * wr;
    const T w4r = w2r * w2r - w2i * w2i, w4i = 2.f * w2r * w2i;
    CMULT(ar[1], ai[1], wr, wi); CMULT(ar[2], ai[2], w2r, w2i); CMULT(ar[3], ai[3], w3r, w3i);
    T br = w4r, bi = w4i;
#pragma unroll
    for (int m = 1; m < 4; ++m) {
        CMULT(ar[4 * m], ai[4 * m], br, bi);
        { T tr = br, ti = bi; CMULT(tr, ti, wr, wi); CMULT(ar[4 * m + 1], ai[4 * m + 1], tr, ti); }
        { T tr = br, ti = bi; CMULT(tr, ti, w2r, w2i); CMULT(ar[4 * m + 2], ai[4 * m + 2], tr, ti); }
        { T tr = br, ti = bi; CMULT(tr, ti, w3r, w3i); CMULT(ar[4 * m + 3], ai[4 * m + 3], tr, ti); }
        CMULT(br, bi, w4r, w4i);
    }
}
constexpr int TWL_OFF = RED_OFF + 256;
__device__ __forceinline__ void fft_fill_twl(const f32x2* TW, const f32x2* PW, LAS unsigned char* lds, int tid) {
    LAS f32x2* twl = (LAS f32x2*)(lds + TWL_OFF);
    twl[tid] = PW[tid]; twl[512 + tid] = TW[16 * (tid & 31)]; twl[1024 + tid] = TW[tid];
}
__device__ __forceinline__ void radix32_combine(const f32x2 (&Dr)[16], const f32x2 (&Di)[16], f32x2 (&X)[32]) {
#pragma unroll
    for (int k = 0; k < 16; ++k) { const int s = 4 * (k & 3) + (k >> 2);
        const float cr = __builtin_cosf(6.28318530717958647692f * (float)k / 32.0f), ci = -__builtin_sinf(6.28318530717958647692f * (float)k / 32.0f);
        const float tr = cr * Dr[s].y - ci * Di[s].y, ti = cr * Di[s].y + ci * Dr[s].y;
        X[k] = (f32x2){Dr[s].x + tr, Di[s].x + ti}; X[k + 16] = (f32x2){Dr[s].x - tr, Di[s].x - ti}; }
}
__device__ __forceinline__ void fft16k(f32x2 (&Rr)[16], f32x2 (&Ri)[16], LAS f32x2* fb, const LAS f32x2* twl, int tid_in) {
    int tid = tid_in; asm volatile("" : "+v"(tid));
    const int j = tid;
    f32x2 X[32];
    __syncthreads();
    dft16(Rr, Ri);
    radix32_combine(Rr, Ri, X);
#pragma unroll
    for (int k = 0; k < 32; ++k) fb[33 * j + k] = X[k];
    __syncthreads();
    {
        const f32x2 w = twl[512 + tid];
#pragma unroll
        for (int s = 0; s < 16; ++s) { const f32x2 v0 = fb[j + (j >> 5) + 528 * (2 * s)], v1 = fb[j + (j >> 5) + 528 * (2 * s + 1)]; Rr[s] = (f32x2){v0.x, v1.x}; Ri[s] = (f32x2){v0.y, v1.y}; }
        const float w2r = w.x * w.x - w.y * w.y, w2i = 2.f * w.x * w.y;
        twiddle16<float>(Rr, Ri, w2r, w2i);
        const f32x2 ur = (f32x2){1.f, w.x}, ui = (f32x2){0.f, w.y};
#pragma unroll
        for (int s = 0; s < 16; ++s) CMULT(Rr[s], Ri[s], ur, ui);
        dft16(Rr, Ri);
        radix32_combine(Rr, Ri, X);
    }
    __syncthreads();
#pragma unroll
    for (int k = 0; k < 32; ++k) fb[(j >> 5) * 1056 + (j & 31) + 33 * k] = X[k];
    __syncthreads();
    {
        const f32x2 w0 = twl[1024 + tid];
        const float c16 = 0.98078528040323043f, s16 = 0.19509032201612825f;
        const f32x2 wr = (f32x2){w0.x, w0.x * c16 + w0.y * s16}, wi = (f32x2){w0.y, w0.y * c16 - w0.x * s16};
#pragma unroll
        for (int r = 0; r < 16; ++r) { const f32x2 v0 = fb[j + (j >> 5) + 1056 * r], v1 = fb[j + (j >> 5) + 528 + 1056 * r]; Rr[r] = (f32x2){v0.x, v1.x}; Ri[r] = (f32x2){v0.y, v1.y}; }
        twiddle16<f32x2>(Rr, Ri, wr, wi);
        dft16(Rr, Ri);
#pragma unroll
        for (int k = 0; k < 16; ++k) { const int s = 4 * (k & 3) + (k >> 2); if (k < s) { const f32x2 tr = Rr[k], ti = Ri[k]; Rr[k] = Rr[s]; Ri[k] = Ri[s]; Rr[s] = tr; Ri[s] = ti; } }
    }
}
typedef unsigned v2u_a4 __attribute__((ext_vector_type(2), aligned(4)));
struct ConvRaw { unsigned lo, hi, nx; };
__device__ __forceinline__ ConvRaw conv_load(const bf16* row, int m) {
    const v2u_a4 v = *(const v2u_a4*)(row + (m > 0 ? 2 * m - 2 : 0));
    ConvRaw r; r.lo = (m > 0) ? v.x : 0u; r.hi = (m > 0) ? v.y : v.x;
    r.nx = (m < SEQ / 2 - 1) ? (unsigned)row[2 * m + 2] : 0u;
    return r;
}
__device__ __forceinline__ void conv_apply(const ConvRaw& r, float w0, float w1, float w2, float b, float& u0, float& u1) {
    const float pm = bfhi(r.lo), p0 = bflo(r.hi), p1 = bfhi(r.hi), pp = __uint_as_float(r.nx << 16);
    u0 = w0 * pm + w1 * p0 + w2 * p1 + b; u1 = w0 * p0 + w1 * p1 + w2 * pp + b;
}
#define FFT_CALL() do { f32x2 Rr_[16], Ri_[16]; \
    _Pragma("unroll") for (int e_ = 0; e_ < 16; ++e_) { Rr_[e_] = (f32x2){re[2 * e_], re[2 * e_ + 1]}; Ri_[e_] = (f32x2){im[2 * e_], im[2 * e_ + 1]}; } \
    fft16k(Rr_, Ri_, fb, TW, tid_in); \
    _Pragma("unroll") for (int e_ = 0; e_ < 16; ++e_) { re[2 * e_] = Rr_[e_].x; re[2 * e_ + 1] = Rr_[e_].y; im[2 * e_] = Ri_[e_].x; im[2 * e_ + 1] = Ri_[e_].y; } } while (0)
__device__ __forceinline__ f32x2 pw_q(f32x2 wt, int q) {
    const float cr = __builtin_cosf(3.14159265358979323846f * (float)q / 32.0f), ci = -__builtin_sinf(3.14159265358979323846f * (float)q / 32.0f);
    return (f32x2){wt.x * cr - wt.y * ci, wt.x * ci + wt.y * cr};
}
__device__ __forceinline__ void hyena_channel(int c, const bf16* PT, const bf16* HT, const float* cw, const float* cb, const float* skip, bf16* Z2T,
                                              f32x4* gscr, LAS unsigned char* lds, int tid_in) {
#define RETID() int tid = tid_in; asm volatile("" : "+v"(tid))
    LAS f32x2* fb = (LAS f32x2*)lds;
    LAS float* red = (LAS float*)(lds + RED_OFF);
    const LAS f32x2* TW = (const LAS f32x2*)(lds + TWL_OFF);
    const int lane = tid_in & 63, wave = tid_in >> 6;
    float sr[16], si[16];
    {
        RETID();
        const int col = 2 * HYW + c; const float w0 = cw[col], w1 = cw[3 * HYW + col], w2 = cw[6 * HYW + col], b = cb[col];
        const bf16* row = PT + (size_t)col * SEQ;
#pragma unroll
        for (int q = 0; q < 16; ++q) { const ConvRaw r = conv_load(row, tid + 512 * q); conv_apply(r, w0, w1, w2, b, sr[q], si[q]); }
    }
#pragma unroll 1
    for (int o = 0; o < 2; ++o) {
        float re[32], im[32];
        float Agr[17], Agi[17], Bgr[17], Bgi[17];
        {
            RETID();
            const bf16* hf = HT + (size_t)(o * 4096 + c) * SEQ;
            const bf16* hb = HT + (size_t)(o * 4096 + 2048 + c) * SEQ;
            float l1 = 0.f;
#pragma unroll
            for (int q = 0; q < 32; ++q) { const int m = tid + 512 * q;
                const unsigned w = (q < 16) ? *(const unsigned*)(hf + 2 * m) : *(const unsigned*)(hb + 2 * m - SEQ);
                re[q] = bflo(w); im[q] = bfhi(w); l1 += fabsf(re[q]) + fabsf(im[q]); }
            l1 = wave_sum(l1);
            __syncthreads();
            if (lane == 0) red[wave] = l1;
            __syncthreads();
            float tot = 0.f;
#pragma unroll
            for (int w = 0; w < 8; ++w) tot += red[w];
            const float scale = 1.0f / (8.0f * (float)SEQ * tot);
            FFT_CALL();
            __syncthreads();
          { RETID();
#pragma unroll
            for (int q = 0; q < 32; ++q) fb[tid + (tid >> 5) + 528 * q] = (f32x2){re[q], im[q]}; }
            __syncthreads();
          { RETID(); const f32x2 wt = TW[tid];
#pragma unroll
            for (int q = 0; q < 17; ++q) {
                const int k = tid + 512 * q;
                if (q < 16 || tid == 0) {
                    const int kp = (SEQ - k) & (SEQ - 1);
                    f32x2 zk; if (q < 16) zk = (f32x2){re[q], im[q]}; else zk = fb[(SEQ / 2) + (SEQ / 64)];
                    const f32x2 zp = fb[kp + (kp >> 5)];
                    const f32x2 w = (q < 16) ? pw_q(wt, q) : (f32x2){0.f, -1.f};
                    const float er = zk.x + zp.x, ei = zk.y - zp.y, orr = zk.y + zp.y, oi = zp.x - zk.x;
                    const float wor = w.x * orr - w.y * oi, woi = w.x * oi + w.y * orr;
                    Agr[q] = (er + wor) * scale; Agi[q] = (ei + woi) * scale; Bgr[q] = (er - wor) * scale; Bgi[q] = (ei - woi) * scale;
                } else { Agr[q] = 0.f; Agi[q] = 0.f; Bgr[q] = 0.f; Bgi[q] = 0.f; }
            } }
        }
#pragma unroll
        for (int q = 0; q < 16; ++q) { re[q] = sr[q]; im[q] = si[q]; re[q + 16] = 0.f; im[q + 16] = 0.f; }
        FFT_CALL();
        __syncthreads();
      { RETID();
#pragma unroll
        for (int q = 0; q < 32; ++q) fb[tid + (tid >> 5) + 528 * q] = (f32x2){re[q], im[q]}; }
        __syncthreads();
      { RETID(); const f32x2 wt = TW[tid];
#pragma unroll
        for (int q = 0; q < 17; ++q) {
            const int k = tid + 512 * q;
            if (q < 16 || tid == 0) {
                const int kp = (SEQ - k) & (SEQ - 1);
                f32x2 zk; if (q < 16) zk = (f32x2){re[q], im[q]}; else zk = fb[(SEQ / 2) + (SEQ / 64)];
                const f32x2 zp = fb[kp + (kp >> 5)];
                const f32x2 w = (q < 16) ? pw_q(wt, q) : (f32x2){0.f, -1.f};
                const float er = zk.x + zp.x, ei = zk.y - zp.y, orr = zk.y + zp.y, oi = zp.x - zk.x;
                const float wor = w.x * orr - w.y * oi, woi = w.x * oi + w.y * orr;
                const float ar = er + wor, ai = ei + woi, br = er - wor, bi = ei - woi;
                const float aar = ar * Agr[q] - ai * Agi[q], aai = ar * Agi[q] + ai * Agr[q];
                const float bbr = br * Bgr[q] - bi * Bgi[q], bbi = br * Bgi[q] + bi * Bgr[q];
                const float eyr = aar + bbr, eyi = aai + bbi, dyr = aar - bbr, dyi = aai - bbi;
                const float oyr = dyr * w.x + dyi * w.y, oyi = dyi * w.x - dyr * w.y;
                if (q < 16) { re[q] = eyr - oyi; im[q] = -eyi - oyr; fb[kp + (kp >> 5)] = (f32x2){eyr + oyi, eyi - oyr}; }
                else fb[(SEQ / 2) + (SEQ / 64)] = (f32x2){eyr - oyi, -eyi - oyr};
            }
        } }
        __syncthreads();
      { RETID();
#pragma unroll
        for (int q = 16; q < 32; ++q) { const f32x2 v = fb[tid + (tid >> 5) + 528 * q]; re[q] = v.x; im[q] = v.y; } }
        ConvRaw graw[16];
      { RETID(); const bf16* grow = PT + (size_t)(o * HYW + c) * SEQ;
#pragma unroll
        for (int q = 0; q < 16; ++q) graw[q] = conv_load(grow, tid + 512 * q); }
        FFT_CALL();
        {
            RETID();
            const int col = o * HYW + c; const float w0 = cw[col], w1 = cw[3 * HYW + col], w2 = cw[6 * HYW + col], b = cb[col];
            const float sk = skip[o * HYW + c]; bf16* orow = Z2T + (size_t)c * SEQ;
#pragma unroll
            for (int q = 0; q < 16; ++q) { float g0, g1; conv_apply(graw[q], w0, w1, w2, b, g0, g1);
                const float o0 = g0 * (re[q] + sk * sr[q]), o1 = g1 * (-im[q] + sk * si[q]);
                sr[q] = o0; si[q] = o1;
                if (o == 1) *(unsigned*)(orow + 2 * (tid + 512 * q)) = pk2(o0, o1); }
        }
    }
#undef RETID
}

typedef unsigned short u16;
__device__ __forceinline__ f32x4 mfma16(bf16x8 a, bf16x8 b, f32x4 c) { return __builtin_amdgcn_mfma_f32_16x16x32_bf16(a, b, c, 0, 0, 0); }

__device__ __forceinline__ void ssm_conv_item(const bf16* PS, const float* cw, const float* cb, bf16* XBC, int item) {
    const int oct = item & 511, rb = item >> 9, ch = 8 * oct, t0 = 32 * rb;
    float w0[8], w1[8], w2[8], bb[8];
#pragma unroll
    for (int e = 0; e < 8; ++e) { w0[e] = cw[ch + e]; w1[e] = cw[XBCW + ch + e]; w2[e] = cw[2 * XBCW + ch + e]; bb[e] = cb[ch + e]; }
    const bf16* src = PS + 2048 + ch;
    v4u prev = (v4u){0u, 0u, 0u, 0u}, cur, nxt;
    if (t0 > 0) prev = *(const v4u*)(src + (size_t)(t0 - 1) * PSW);
    cur = *(const v4u*)(src + (size_t)t0 * PSW);
#pragma unroll 4
    for (int r = 0; r < 32; ++r) {
        const int t = t0 + r;
        nxt = (v4u){0u, 0u, 0u, 0u};
        if (t + 1 < SEQ) nxt = *(const v4u*)(src + (size_t)(t + 1) * PSW);
        float o[8];
#pragma unroll
        for (int e = 0; e < 4; ++e) {
            const unsigned pw = prev[e], cwd = cur[e], nw = nxt[e];
            const float x0 = w0[2 * e] * bflo(pw) + w1[2 * e] * bflo(cwd) + w2[2 * e] * bflo(nw) + bb[2 * e];
            const float x1 = w0[2 * e + 1] * bfhi(pw) + w1[2 * e + 1] * bfhi(cwd) + w2[2 * e + 1] * bfhi(nw) + bb[2 * e + 1];
            o[2 * e] = silu_f(x0); o[2 * e + 1] = silu_f(x1);
        }
        v4u ov; ov.x = pk2(o[0], o[1]); ov.y = pk2(o[2], o[3]); ov.z = pk2(o[4], o[5]); ov.w = pk2(o[6], o[7]);
        *(v4u*)(XBC + (size_t)t * XBCW + ch) = ov;
        prev = cur; cur = nxt;
    }
}
__device__ __forceinline__ void ssm_dt_tile(int tile, const bf16* XN, const bf16* Wdt, const float* rstd, float* DTRAW, int lane) {
    const int li = lane & 15, g = lane >> 4, t0 = 16 * tile;
    f32x4 acc0 = (f32x4){0.f, 0.f, 0.f, 0.f}, acc1 = (f32x4){0.f, 0.f, 0.f, 0.f};
    const bf16* xa = XN + (size_t)(t0 + li) * DM + 8 * g;
    const bf16* wb0 = Wdt + (size_t)li * DM + 8 * g;
    const bf16* wb1 = wb0 + (size_t)16 * DM;
#pragma unroll 8
    for (int ks = 0; ks < DM / 32; ++ks) {
        const bf16x8 a = *(const bf16x8*)(xa + 32 * ks), b0 = *(const bf16x8*)(wb0 + 32 * ks), b1 = *(const bf16x8*)(wb1 + 32 * ks);
        acc0 = mfma16(a, b0, acc0); acc1 = mfma16(a, b1, acc1);
    }
#pragma unroll
    for (int r = 0; r < 4; ++r) { const float rs = rstd[t0 + 4 * g + r];
        DTRAW[(size_t)(t0 + 4 * g + r) * 32 + li] = acc0[r] * rs; DTRAW[(size_t)(t0 + 4 * g + r) * 32 + 16 + li] = acc1[r] * rs; }
}
constexpr int XT_STRIDE = 264;
constexpr int BM_STRIDE = 136;
constexpr int SSD_XT_OFF = 0, SSD_BM_OFF = 64 * XT_STRIDE * 2  , SSD_ARR_OFF = SSD_BM_OFF + 256 * BM_STRIDE * 2  , SSD_SIN_OFF = SSD_ARR_OFF + 4096  ;
static_assert(SSD_SIN_OFF + 2 * 64 * BM_STRIDE * 2 <= MISC_OFF, "SSD LDS map");
__device__ __forceinline__ void ssd_stage_xb(int c, int h, const bf16* XBC, LAS unsigned char* lds, int tid) {
    LAS u16* XT = (LAS u16*)(lds + SSD_XT_OFF);
    LAS u16* Bm = (LAS u16*)(lds + SSD_BM_OFF);
    const int t0 = c * QCH, grp = h >> 2;
#pragma unroll
    for (int i = 0; i < 4; ++i) { const int id = tid + 512 * i, s = id >> 3, pc = id & 7;
        const v4u v = *(const v4u*)(XBC + (size_t)(t0 + s) * XBCW + h * HDIM + 8 * pc);
#pragma unroll
        for (int e = 0; e < 4; ++e) { XT[(8 * pc + 2 * e) * XT_STRIDE + s] = (u16)(v[e] & 0xffffu); XT[(8 * pc + 2 * e + 1) * XT_STRIDE + s] = (u16)(v[e] >> 16); } }
#pragma unroll
    for (int i = 0; i < 8; ++i) { const int id = tid + 512 * i, s = id >> 4, nc = id & 15;
        const v4u v = *(const v4u*)(XBC + (size_t)(t0 + s) * XBCW + SSW + grp * NST + 8 * nc);
        *(LAS v4u*)(Bm + s * BM_STRIDE + 8 * nc) = v; }
}
__device__ __forceinline__ void ssd_states_unit(int c, int h, const bf16* XBC, const float* DTRAW, const float* alog, const float* dtbias, float* DTF, float* DTB, float* ACS, float* RB, float* S,
                                                LAS unsigned char* lds, int tid) {
    const int lane = tid & 63, wave = tid >> 6, li = lane & 15, g = lane >> 4;
    LAS u16* XT = (LAS u16*)(lds + SSD_XT_OFF);
    LAS u16* Bm = (LAS u16*)(lds + SSD_BM_OFF);
    LAS float* wf = (LAS float*)(lds + SSD_ARR_OFF);
    LAS float* wb = wf + 256;
    const int t0 = c * QCH;
    __syncthreads();
    ssd_stage_xb(c, h, XBC, lds, tid);
    if (wave < 2) {
        const int dir = wave;
        const float A = -expf(alog[dir * 32 + h]), bias = dtbias[dir * 32 + h];
        float dtv[4], inc[4];
#pragma unroll
        for (int e = 0; e < 4; ++e) dtv[e] = softplus_f(DTRAW[(size_t)(t0 + 4 * lane + e) * 32 + h] + bias);
        inc[0] = dtv[0] * A; inc[1] = inc[0] + dtv[1] * A; inc[2] = inc[1] + dtv[2] * A; inc[3] = inc[2] + dtv[3] * A;
        float sc = inc[3];
#pragma unroll
        for (int o = 1; o < 64; o <<= 1) { const float t = __shfl_up(sc, o); if (lane >= o) sc += t; }
        const float excl = sc - inc[3], total = rdlane(sc, 63);
#pragma unroll
        for (int e = 0; e < 4; ++e) { const int tl = 4 * lane + e; const size_t o = (size_t)(t0 + tl) * 32 + h; const float ic = excl + inc[e];
            if (dir == 0) { wf[tl] = __expf(total - ic) * dtv[e]; DTF[o] = dtv[e]; ACS[o] = ic; }
            else { const float pre = ic - dtv[e] * A; wb[tl] = __expf(pre) * dtv[e]; DTB[o] = dtv[e]; RB[o] = total - pre; } }
    }
    __syncthreads();
    f32x4 acc[2][4];
#pragma unroll
    for (int d = 0; d < 2; ++d)
#pragma unroll
        for (int p = 0; p < 4; ++p) acc[d][p] = (f32x4){0.f, 0.f, 0.f, 0.f};
    const int n = 16 * wave + li;
#pragma unroll 2
    for (int ks = 0; ks < 8; ++ks) {
        const int s0 = 32 * ks + 8 * g;
        float bv[8];
#pragma unroll
        for (int j = 0; j < 8; ++j) bv[j] = bf2f(Bm[(s0 + j) * BM_STRIDE + n]);
        const f32x4 wf0 = *(const LAS f32x4*)(wf + s0), wf1 = *(const LAS f32x4*)(wf + s0 + 4), wb0 = *(const LAS f32x4*)(wb + s0), wb1 = *(const LAS f32x4*)(wb + s0 + 4);
        v4u fa, fbk;
        fa.x = pk2(bv[0] * wf0.x, bv[1] * wf0.y); fa.y = pk2(bv[2] * wf0.z, bv[3] * wf0.w); fa.z = pk2(bv[4] * wf1.x, bv[5] * wf1.y); fa.w = pk2(bv[6] * wf1.z, bv[7] * wf1.w);
        fbk.x = pk2(bv[0] * wb0.x, bv[1] * wb0.y); fbk.y = pk2(bv[2] * wb0.z, bv[3] * wb0.w); fbk.z = pk2(bv[4] * wb1.x, bv[5] * wb1.y); fbk.w = pk2(bv[6] * wb1.z, bv[7] * wb1.w);
        const bf16x8 af = __builtin_bit_cast(bf16x8, fa), ab = __builtin_bit_cast(bf16x8, fbk);
#pragma unroll
        for (int pt = 0; pt < 4; ++pt) {
            const bf16x8 xf = *(const LAS bf16x8*)(XT + (16 * pt + li) * XT_STRIDE + s0);
            acc[0][pt] = mfma16(af, xf, acc[0][pt]); acc[1][pt] = mfma16(ab, xf, acc[1][pt]);
        }
    }
#pragma unroll
    for (int d = 0; d < 2; ++d) { float* So = S + ((size_t)(c * 2 + d) * NHEAD + h) * (HDIM * NST);
#pragma unroll
        for (int pt = 0; pt < 4; ++pt) *(f32x4*)(So + (16 * pt + li) * NST + 16 * wave + 4 * g) = acc[d][pt]; }
}
__device__ __forceinline__ void ssd_scan_item(int e4, const float* S, const float* ACS, const float* RB, bf16* SIN) {
    const int e = 4 * e4, dir = e / (NHEAD * HDIM * NST), h = (e / (HDIM * NST)) % NHEAD;
    const size_t cs = (size_t)2 * NHEAD * HDIM * NST;
    f32x4 st = (f32x4){0.f, 0.f, 0.f, 0.f};
#pragma unroll 1
    for (int c0 = 0; c0 < NCH; c0 += 8) {
        f32x4 sv[8]; float tv[8];
#pragma unroll
        for (int i = 0; i < 8; ++i) { const int c = dir ? (NCH - 1 - (c0 + i)) : (c0 + i);
            sv[i] = *(const f32x4*)(S + c * cs + e);
            tv[i] = dir ? RB[(size_t)(c * QCH) * 32 + h] : ACS[(size_t)(c * QCH + QCH - 1) * 32 + h]; }
#pragma unroll
        for (int i = 0; i < 8; ++i) { const int c = dir ? (NCH - 1 - (c0 + i)) : (c0 + i);
            v2u o; o.x = pk2(st.x, st.y); o.y = pk2(st.z, st.w); *(v2u*)(SIN + c * cs + e) = o;
            st = st * __expf(tv[i]) + sv[i]; }
    }
}
__device__ __forceinline__ void ssd_out_unit(int c, int h, const bf16* XBC, const bf16* PS, const float* DTF, const float* DTB, const float* ACS, const float* RB, const bf16* SIN,
                                             float Dskip, bf16* YMIX, float* SSQ, LAS unsigned char* lds, int tid) {
    const int lane = tid & 63, wave = tid >> 6, li = lane & 15, g = lane >> 4;
    LAS u16* XT = (LAS u16*)(lds + SSD_XT_OFF);
    LAS u16* Bm = (LAS u16*)(lds + SSD_BM_OFF);
    LAS float* acsL = (LAS float*)(lds + SSD_ARR_OFF);
    LAS float* rbL = acsL + 256; LAS float* dtfL = acsL + 512; LAS float* dtbL = acsL + 768;
    LAS u16* SF = (LAS u16*)(lds + SSD_SIN_OFF);
    LAS u16* SB = SF + 64 * BM_STRIDE;
    const int t0 = c * QCH, grp = h >> 2;
    __syncthreads();
    ssd_stage_xb(c, h, XBC, lds, tid);
    if (tid < 256) { const size_t o = (size_t)(t0 + tid) * 32 + h; acsL[tid] = ACS[o]; rbL[tid] = RB[o]; dtfL[tid] = DTF[o]; dtbL[tid] = DTB[o]; }
    {
        const bf16* sf = SIN + ((size_t)(c * 2 + 0) * NHEAD + h) * (HDIM * NST);
        const bf16* sb = SIN + ((size_t)(c * 2 + 1) * NHEAD + h) * (HDIM * NST);
#pragma unroll
        for (int i = 0; i < 2; ++i) { const int id = tid + 512 * i, p = id >> 4, nc = id & 15;
            *(LAS v4u*)(SF + p * BM_STRIDE + 8 * nc) = *(const v4u*)(sf + p * NST + 8 * nc);
            *(LAS v4u*)(SB + p * BM_STRIDE + 8 * nc) = *(const v4u*)(sb + p * NST + 8 * nc); }
    }
    __syncthreads();
#pragma unroll 1
    for (int lt = 0; lt < 2; ++lt) {
        const int l = 32 * wave + 16 * lt + li;
        bf16x8 cf[4];
#pragma unroll
        for (int kn = 0; kn < 4; ++kn) cf[kn] = *(const bf16x8*)(XBC + (size_t)(t0 + l) * XBCW + SSW + NGRP * NST + grp * NST + 32 * kn + 8 * g);
        const float acs_l = acsL[l], rb_l = rbL[l];
        f32x4 yacc[4];
#pragma unroll
        for (int pt = 0; pt < 4; ++pt) yacc[pt] = (f32x4){0.f, 0.f, 0.f, 0.f};
#pragma unroll 2
        for (int ks = 0; ks < 8; ++ks) {
            unsigned mw[4];
#pragma unroll
            for (int st = 0; st < 2; ++st) {
                const int sb0 = 32 * ks + 16 * st;
                f32x4 d = (f32x4){0.f, 0.f, 0.f, 0.f};
#pragma unroll
                for (int kn = 0; kn < 4; ++kn) { const bf16x8 bfrag = *(const LAS bf16x8*)(Bm + (sb0 + li) * BM_STRIDE + 32 * kn + 8 * g); d = mfma16(bfrag, cf[kn], d); }
                const int s4 = sb0 + 4 * g;
                const f32x4 as4 = *(const LAS f32x4*)(acsL + s4), rs4 = *(const LAS f32x4*)(rbL + s4), df4 = *(const LAS f32x4*)(dtfL + s4), db4 = *(const LAS f32x4*)(dtbL + s4);
                float mv[4];
#pragma unroll
                for (int r = 0; r < 4; ++r) { const int s = s4 + r;
                    const float wfw = (s <= l) ? __expf(fminf(acs_l - as4[r], 0.f)) * df4[r] : 0.f;
                    const float wbw = (s >= l) ? __expf(fminf(rb_l - rs4[r], 0.f)) * db4[r] : 0.f;
                    mv[r] = d[r] * (wfw + wbw); }
                mw[2 * st] = pk2(mv[0], mv[1]); mw[2 * st + 1] = pk2(mv[2], mv[3]);
            }
            v4u mfv; mfv.x = mw[0]; mfv.y = mw[1]; mfv.z = mw[2]; mfv.w = mw[3];
            const bf16x8 mfrag = __builtin_bit_cast(bf16x8, mfv);
#pragma unroll
            for (int pt = 0; pt < 4; ++pt) {
                const LAS u16* xr = XT + (16 * pt + li) * XT_STRIDE + 32 * ks + 4 * g;
                const v2u x0 = *(const LAS v2u*)xr, x1 = *(const LAS v2u*)(xr + 16);
                v4u xv; xv.x = x0.x; xv.y = x0.y; xv.z = x1.x; xv.w = x1.y;
                yacc[pt] = mfma16(__builtin_bit_cast(bf16x8, xv), mfrag, yacc[pt]);
            }
        }
        const float ef = __expf(acs_l), eb = __expf(rb_l);
#pragma unroll
        for (int pt = 0; pt < 4; ++pt) {
            f32x4 df = (f32x4){0.f, 0.f, 0.f, 0.f}, db = (f32x4){0.f, 0.f, 0.f, 0.f};
#pragma unroll
            for (int kn = 0; kn < 4; ++kn) {
                const bf16x8 sfr = *(const LAS bf16x8*)(SF + (16 * pt + li) * BM_STRIDE + 32 * kn + 8 * g);
                const bf16x8 sbr = *(const LAS bf16x8*)(SB + (16 * pt + li) * BM_STRIDE + 32 * kn + 8 * g);
                df = mfma16(sfr, cf[kn], df); db = mfma16(sbr, cf[kn], db);
            }
            yacc[pt] = yacc[pt] + df * ef + db * eb;
        }
        const int t = t0 + l;
        float ssq = 0.f;
#pragma unroll
        for (int pt = 0; pt < 4; ++pt) {
            const int p = 16 * pt + 4 * g;
            const v2u xw = *(const v2u*)(XBC + (size_t)t * XBCW + h * HDIM + p);
            const v2u zw = *(const v2u*)(PS + (size_t)t * PSW + h * HDIM + p);
            float y0 = (yacc[pt][0] + Dskip * bflo(xw.x)) * silu_f(bflo(zw.x));
            float y1 = (yacc[pt][1] + Dskip * bfhi(xw.x)) * silu_f(bfhi(zw.x));
            float y2 = (yacc[pt][2] + Dskip * bflo(xw.y)) * silu_f(bflo(zw.y));
            float y3 = (yacc[pt][3] + Dskip * bfhi(xw.y)) * silu_f(bfhi(zw.y));
            ssq += (y0 * y0 + y1 * y1) + (y2 * y2 + y3 * y3);
            v2u o; o.x = pk2(y0, y1); o.y = pk2(y2, y3);
            *(v2u*)(YMIX + (size_t)t * DM + HYW + h * HDIM + p) = o;
        }
        ssq += __shfl_xor(ssq, 16); ssq += __shfl_xor(ssq, 32);
        if (g == 0) SSQ[(size_t)t * 32 + h] = ssq;
    }
}
__device__ __forceinline__ void mixer_norm_unit(int tb, const bf16* Z2T, const float* hog, const float* SSQ, const float* sog, bf16* YMIX, LAS unsigned char* lds, int tid) {
    LAS float* red = (LAS float*)lds;
    LAS float* rsh = (LAS float*)(lds + 16640);
    LAS float* rss = rsh + 64;
    LAS u16* tile = (LAS u16*)(lds + 20480);
    constexpr int TS = 264;
    const int t0 = 64 * tb, j = tid & 7, cc = tid >> 3;
    __syncthreads();
    float ps[8];
#pragma unroll
    for (int e = 0; e < 8; ++e) ps[e] = 0.f;
#pragma unroll 16
    for (int cbk = 0; cbk < 32; ++cbk) {
        const v4u v = *(const v4u*)(Z2T + (size_t)(64 * cbk + cc) * SEQ + t0 + 8 * j);
#pragma unroll
        for (int e = 0; e < 4; ++e) { const float a = bflo(v[e]), b = bfhi(v[e]); ps[2 * e] += a * a; ps[2 * e + 1] += b * b; }
    }
#pragma unroll
    for (int e = 0; e < 8; ++e) red[cc * 65 + 8 * j + e] = ps[e];
    __syncthreads();
    if (tid < 64) { float s = 0.f; for (int k = 0; k < 64; ++k) s += red[k * 65 + tid]; rsh[tid] = 1.0f / sqrtf(s * (1.f / HYW) + EPS); }
    { const int tk = tid >> 3, gq = tid & 7; const f32x4 q = *(const f32x4*)(SSQ + (size_t)(t0 + tk) * 32 + 4 * gq); rss[tk * 8 + gq] = 1.0f / sqrtf(((q.x + q.y) + (q.z + q.w)) * (1.f / 256.f) + EPS); }
    v4u cur[4], nxt[4];
#pragma unroll
    for (int i = 0; i < 4; ++i) cur[i] = *(const v4u*)(Z2T + (size_t)(cc + 64 * i) * SEQ + t0 + 8 * j);
#pragma unroll 1
    for (int cb4 = 0; cb4 < 8; ++cb4) {
        if (cb4 + 1 < 8) {
#pragma unroll
            for (int i = 0; i < 4; ++i) nxt[i] = *(const v4u*)(Z2T + (size_t)(256 * (cb4 + 1) + cc + 64 * i) * SEQ + t0 + 8 * j); }
#pragma unroll
        for (int i = 0; i < 4; ++i)
#pragma unroll
            for (int e = 0; e < 4; ++e) { tile[(8 * j + 2 * e) * TS + cc + 64 * i] = (u16)(cur[i][e] & 0xffffu); tile[(8 * j + 2 * e + 1) * TS + cc + 64 * i] = (u16)(cur[i][e] >> 16); }
        __syncthreads();
        { const int tk = tid >> 3; const float r = rsh[tk];
#pragma unroll
          for (int i = 0; i < 4; ++i) { const int c8 = (tid & 7) + 8 * i; const v4u w = *(const LAS v4u*)(tile + tk * TS + 8 * c8);
            const f32x4 g0 = *(const f32x4*)(hog + 256 * cb4 + 8 * c8), g1 = *(const f32x4*)(hog + 256 * cb4 + 8 * c8 + 4);
            v4u o; o.x = pk2(bflo(w.x) * r * g0.x, bfhi(w.x) * r * g0.y); o.y = pk2(bflo(w.y) * r * g0.z, bfhi(w.y) * r * g0.w);
            o.z = pk2(bflo(w.z) * r * g1.x, bfhi(w.z) * r * g1.y); o.w = pk2(bflo(w.w) * r * g1.z, bfhi(w.w) * r * g1.w);
            *(v4u*)(YMIX + (size_t)(t0 + tk) * DM + 256 * cb4 + 8 * c8) = o; } }
        __syncthreads();
#pragma unroll
        for (int i = 0; i < 4; ++i) cur[i] = nxt[i];
    }
#pragma unroll 8
    for (int i = 0; i < 32; ++i) { const int id = tid + 512 * i, tk = id >> 8, oc = id & 255;
        bf16* ptr = YMIX + (size_t)(t0 + tk) * DM + HYW + 8 * oc; const v4u w = *(const v4u*)ptr; const float r = rss[tk * 8 + (oc >> 5)];
        const f32x4 g0 = *(const f32x4*)(sog + 8 * oc), g1 = *(const f32x4*)(sog + 8 * oc + 4);
        v4u o; o.x = pk2(bflo(w.x) * r * g0.x, bfhi(w.x) * r * g0.y); o.y = pk2(bflo(w.y) * r * g0.z, bfhi(w.y) * r * g0.w);
        o.z = pk2(bflo(w.z) * r * g1.x, bfhi(w.z) * r * g1.y); o.w = pk2(bflo(w.w) * r * g1.z, bfhi(w.w) * r * g1.w);
        *(v4u*)ptr = o; }
}

#ifndef MK_ONE_LAUNCH
#define MK_ONE_LAUNCH 1
#endif
constexpr int NPH = 12, PH_FINAL = 1 + DEPTH * NPH, PH_TOTAL = PH_FINAL + 1;
struct Args { const float* in[N_INPUTS]; float* out; unsigned char* ws; int ph_lo, ph_hi, use_bar, pad; };

__global__ void __launch_bounds__(512, 2) mk_fwd(Args a) {
    extern __shared__ __attribute__((aligned(16))) unsigned char lds_raw[];
    LAS unsigned char* lds = (LAS unsigned char*)lds_raw;
    const int G = gridDim.x, bid = blockIdx.x;
    const int wave_s = __builtin_amdgcn_readfirstlane((int)threadIdx.x >> 6);
    volatile LAS unsigned* MISC = (volatile LAS unsigned*)(lds + MISC_OFF);
    if (threadIdx.x < 64) MISC[threadIdx.x] = 0u;
    __syncthreads();
    unsigned* ctl = (unsigned*)(a.ws + WS_CTL);
    XcdBarrier bar; bar.bar = ctl + CW_BAR; bar.x = 0; bar.st = MISC + 8;
    if (a.use_bar) bar = xcd_barrier_post(ctl + CW_BAR, MISC + 8);
    const int lo = a.ph_lo, hi = a.ph_hi;
#ifndef MK_C1
#define MK_C1 1
#endif
#ifndef MK_C2
#define MK_C2 1
#endif
#ifndef MK_REP_MASK
#define MK_REP_MASK 0u
#endif
#define REPS(k) ((((unsigned)MK_REP_MASK >> (k)) & 1u) ? 2 : 1)
#define REP_LOOP(k) for (int rep_ = 0; rep_ < REPS(k); ++rep_)
#define REP_SEAM(k) do { if (rep_ + 1 < REPS(k)) xcd_barrier(bar); } while (0)
#ifndef MK_TAPS
#define MK_TAPS 1
#endif
#ifndef MK_PHMASK
#define MK_PHMASK 0xFFFFu
#endif
#define IN(p) (lo <= (p) && (p) < hi)
#define INL(k) (((MK_PHMASK >> (k)) & 1u) && IN(pb + (k)))
#define SEAM(p) do { if (IN(p) && IN((p) + 1)) xcd_barrier(bar); } while (0)
#define CAS __attribute__((address_space(4)))
#define PHASE_BEGIN \
    const char CAS* kp = (const char CAS*)__builtin_amdgcn_kernarg_segment_ptr(); asm volatile("" : "+s"(kp)); \
    unsigned char* ws = *(unsigned char* const CAS*)(kp + 8 * (N_INPUTS + 1)); \
    unsigned z_ = 0u; asm volatile("" : "+v"(z_)); int wv_ = wave_s; asm volatile("" : "+s"(wv_)); \
    const int tid = wv_ * 64 + (int)__builtin_amdgcn_mbcnt_hi(~0u, __builtin_amdgcn_mbcnt_lo(~0u, z_)); \
    const int lane = tid & 63, wave = wave_s; \
    const int vcu = (G % 8 == 0) ? (bid % 8) * (G / 8) + bid / 8 : bid; \
    const int gw = vcu * 8 + wave, NGW = G * 8; (void)lane; (void)gw; (void)NGW; (void)ws
#define INP(i) (*(const float* const CAS*)(kp + 8 * (i)))
#define OUTP() (*(float* const CAS*)(kp + 8 * N_INPUTS))
#define WSP(T, off) ((T*)(ws + (off)))

    if (IN(0)) {
        PHASE_BEGIN;
        f32x2* TW = WSP(f32x2, WS_TW); f32x2* PW = WSP(f32x2, WS_PW);
        for (int i = bid * 512 + tid; i < 16384 + 8193; i += G * 512) {
            float s, c;
            if (i < 16384) { sincospif((float)i / 8192.0f, &s, &c); TW[i] = (f32x2){c, -s}; }
            else { const int k = i - 16384; sincospif((float)k / 16384.0f, &s, &c); PW[k] = (f32x2){c, -s}; }
        }
    }

#pragma unroll 1
    for (int l = 0; l < DEPTH; ++l) {
        const int pb = 1 + l * NPH;
        if (INL(0)) REP_LOOP(0) {
            PHASE_BEGIN;
            LAS float* scr = (LAS float*)(lds + wave * 16384);
            const float* win = INP(I_WIN) + (size_t)l * DM * NIN; const float* wo = INP(I_WO) + (size_t)l * DM * DM;
            const float* wup = INP(I_WUP) + (size_t)l * DM * DFF; const float* wdn = INP(I_WDN) + (size_t)l * DFF * DM;
            bf16* WIN = WSP(bf16, WS_WIN); bf16* WOUT = WSP(bf16, WS_WOUT); bf16* WUP = WSP(bf16, WS_WUP); bf16* WDN = WSP(bf16, WS_WDN);
            const float* gmix = INP(I_NMG) + (size_t)l * DM; const float* gmlp = INP(I_NLG) + (size_t)l * DM;
            constexpr int IT_IN = (DM / 64) * (NIN / 32), IT_O = (DM / 64) * (DM / 32), IT_UP = (DM / 64) * (DFF / 32), IT_DN = (DFF / 64) * (DM / 32);
            for (int it = gw; it < IT_IN + IT_O + IT_UP + IT_DN; it += NGW) {
                int r = it;
                if (r < IT_IN) { transpose_item(win, DM, NIN, WIN, scr, r, lane, gmix); continue; } r -= IT_IN;
                if (r < IT_O) { transpose_item(wo, DM, DM, WOUT, scr, r, lane, nullptr); continue; } r -= IT_O;
                if (r < IT_UP) { transpose_item(wup, DM, DFF, WUP, scr, r, lane, gmlp); continue; } r -= IT_UP;
                transpose_item(wdn, DFF, DM, WDN, scr, r, lane, nullptr);
            }
            if (l == 0) { const float* xin = INP(I_X); bf16* XB = WSP(bf16, WS_XN); float* sa = WSP(float, WS_SSQA);
                for (int m = gw; m < SEQ; m += NGW) prep_row(xin + (size_t)m * DM, XB + (size_t)m * DM, sa + m, lane); }
            else { const int i = bid * 512 + tid; if (i < SEQ) rstd_reduce(WSP(const float, WS_PARTA), WSP(float, WS_SSQA), i);
                   if (bid == 0) for (int i2 = G * 512 + tid; i2 < SEQ; i2 += 512) rstd_reduce(WSP(const float, WS_PARTA), WSP(float, WS_SSQA), i2); }
            const float* w1 = INP(I_PW1) + (size_t)l * 33 * 64; const float* b1 = INP(I_PB1) + (size_t)l * 64;
            const float* w2 = INP(I_PW2) + (size_t)l * 64 * 64; const float* b2 = INP(I_PB2) + (size_t)l * 64;
            const float* w3 = INP(I_PW3) + (size_t)l * 64 * 64; const float* b3 = INP(I_PB3) + (size_t)l * 64;
            const float* sf = INP(I_SF) + (size_t)l * 3 * 64; bf16* H3 = WSP(bf16, WS_H3);
            for (int t = gw; t < SEQ; t += NGW) posmlp_row(t, w1, b1, w2, b2, w3, b3, sf, H3 + (size_t)t * 64, lane);
            REP_SEAM(0);
        }
        SEAM(pb + 0);
        if (INL(1)) REP_LOOP(1) {
            PHASE_BEGIN;
            pg8::Gemm g{WSP(bf16, WS_WIN), WSP(bf16, WS_XN), 3 * HYW, SEQ, DM}; pg8::StaticOrder S; S.init(3 * HYW, SEQ, G, bid);
            pg8::EpiBf16P<0, 2> E{WSP(bf16, WS_PT), SEQ, WSP(const float, WS_SSQA)};
            pg8::gemm_phase<pg8::EpiBf16P<0, 2>, pg8::StaticOrder, true, true>(lds, g, S, E, tid);
            REP_SEAM(1);
        }
        if (INL(2)) {
            PHASE_BEGIN;
            pg8::Gemm g{WSP(bf16, WS_XN), WSP(bf16, WS_WIN) + (size_t)3 * HYW * DM, SEQ, PSW, DM}; pg8::StaticOrder S; S.init(SEQ, PSW, G, bid);
            pg8::EpiBf16P<0, 1> E{WSP(bf16, WS_PS), PSW, WSP(const float, WS_SSQA)};
            pg8::gemm_phase<pg8::EpiBf16P<0, 1>, pg8::StaticOrder, true, true>(lds, g, S, E, tid);
        }
        if (INL(2)) REP_LOOP(12) {
            PHASE_BEGIN;
            if (rep_) xcd_barrier(bar);
            if (MK_TAPS) taps_gemm(INP(I_WOUTF) + (size_t)l * 64 * NTAP, WSP(bf16, WS_H3), WSP(bf16, WS_HT), gw, NGW, lane);
        }
        SEAM(pb + 2);
        if (MK_C1 && INL(3)) REP_LOOP(13) {
            PHASE_BEGIN;
            if (rep_) xcd_barrier(bar);
            for (int tile = gw; tile < SEQ / 16; tile += NGW) ssm_dt_tile(tile, WSP(bf16, WS_XN), WSP(bf16, WS_WIN) + (size_t)(3 * HYW + PSW) * DM, WSP(const float, WS_SSQA), WSP(float, WS_DTRAW), lane);
            { const float* cw = INP(I_SCW) + (size_t)l * 3 * XBCW; const float* cb = INP(I_SCB) + (size_t)l * XBCW;
              for (int it = bid * 512 + tid; it < 512 * 512; it += G * 512) ssm_conv_item(WSP(bf16, WS_PS), cw, cb, WSP(bf16, WS_XBC), it); }
        }
        if (MK_C2 && INL(3)) REP_LOOP(3) {
            PHASE_BEGIN;
            if (rep_) xcd_barrier(bar);
            const float* cw = INP(I_HCW) + (size_t)l * 3 * 3 * HYW; const float* cb = INP(I_HCB) + (size_t)l * 3 * HYW; const float* sk = INP(I_SKIP) + (size_t)l * 2 * HYW;
            __syncthreads(); fft_fill_twl(WSP(f32x2, WS_TW), WSP(f32x2, WS_PW), lds, tid); __syncthreads();
            for (int c = bid; c < HYW; c += G) hyena_channel(c, WSP(bf16, WS_PT), WSP(bf16, WS_HT), cw, cb, sk, WSP(bf16, WS_Z2T), (f32x4*)(ws + WS_GSCR + (size_t)bid * GSCR_PER_WG), lds, tid);
        }
        SEAM(pb + 3);
        if (INL(4)) REP_LOOP(4) { PHASE_BEGIN; if (rep_) xcd_barrier(bar);
            for (int u = bid; u < NCH * NHEAD; u += G) ssd_states_unit(u >> 5, u & 31, WSP(bf16, WS_XBC), WSP(float, WS_DTRAW), INP(I_ALOG) + (size_t)l * 64, INP(I_DTB) + (size_t)l * 64,
                                                                       WSP(float, WS_DTF), WSP(float, WS_DTB), WSP(float, WS_ACS), WSP(float, WS_RB), WSP(float, WS_S), lds, tid); }
        SEAM(pb + 4);
        if (INL(5)) REP_LOOP(5) { PHASE_BEGIN; if (rep_) xcd_barrier(bar);
            for (int e4 = bid * 512 + tid; e4 < 2 * NHEAD * HDIM * NST / 4; e4 += G * 512) ssd_scan_item(e4, WSP(float, WS_S), WSP(float, WS_ACS), WSP(float, WS_RB), WSP(bf16, WS_SIN)); }
        SEAM(pb + 5);
        if (INL(6)) REP_LOOP(6) { PHASE_BEGIN; if (rep_) xcd_barrier(bar); const float* sd = INP(I_SD) + (size_t)l * NHEAD;
            for (int u = bid; u < NCH * NHEAD; u += G) ssd_out_unit(u >> 5, u & 31, WSP(bf16, WS_XBC), WSP(bf16, WS_PS), WSP(float, WS_DTF), WSP(float, WS_DTB), WSP(float, WS_ACS), WSP(float, WS_RB),
                                                                    WSP(bf16, WS_SIN), sd[u & 31], WSP(bf16, WS_YMIX), WSP(float, WS_SSQ), lds, tid); }
        SEAM(pb + 6);
        if (INL(7)) { PHASE_BEGIN;
            for (int tb = bid; tb < SEQ / 64; tb += G) mixer_norm_unit(tb, WSP(bf16, WS_Z2T), INP(I_HOG) + (size_t)l * HYW, WSP(float, WS_SSQ), INP(I_SOG) + (size_t)l * SSW, WSP(bf16, WS_YMIX), lds, tid); }
        SEAM(pb + 7);
        if (INL(8)) { PHASE_BEGIN;
            pg8::Gemm g{WSP(bf16, WS_YMIX), WSP(bf16, WS_WOUT), SEQ, DM, DM}; pg8::StaticOrder S; S.init(SEQ, DM, G, bid);
            pg8::EpiRes E{(l == 0) ? INP(I_X) : WSP(const float, WS_X), WSP(float, WS_X), WSP(bf16, WS_XN), WSP(float, WS_PARTB), DM, SEQ};
            pg8::gemm_phase<pg8::EpiRes, pg8::StaticOrder, true, true>(lds, g, S, E, tid); }
        SEAM(pb + 8);
        if (INL(9)) { PHASE_BEGIN; const int i = bid * 512 + tid; if (i < SEQ) rstd_reduce(WSP(const float, WS_PARTB), WSP(float, WS_SSQB), i);
            if (bid == 0) for (int i2 = G * 512 + tid; i2 < SEQ; i2 += 512) rstd_reduce(WSP(const float, WS_PARTB), WSP(float, WS_SSQB), i2); }
        SEAM(pb + 9);
        if (INL(10)) REP_LOOP(10) { PHASE_BEGIN; if (rep_) xcd_barrier(bar);
            pg8::Gemm g{WSP(bf16, WS_XN), WSP(bf16, WS_WUP), SEQ, DFF, DM}; pg8::StaticOrder S; S.init(SEQ, DFF, G, bid);
            pg8::EpiBf16P<1, 1> E{WSP(bf16, WS_H), DFF, WSP(const float, WS_SSQB)};
            pg8::gemm_phase<pg8::EpiBf16P<1, 1>, pg8::StaticOrder, true, true>(lds, g, S, E, tid); }
        SEAM(pb + 10);
        if (INL(11)) { PHASE_BEGIN;
            pg8::Gemm g{WSP(bf16, WS_H), WSP(bf16, WS_WDN), SEQ, DM, DFF}; pg8::StaticOrder S; S.init(SEQ, DM, G, bid);
            pg8::EpiRes E{WSP(const float, WS_X), WSP(float, WS_X), WSP(bf16, WS_XN), WSP(float, WS_PARTA), DM, SEQ};
            pg8::gemm_phase<pg8::EpiRes, pg8::StaticOrder, true, true>(lds, g, S, E, tid); }
        SEAM(pb + 11);
    }
    if (IN(PH_FINAL)) { PHASE_BEGIN; const float* X = WSP(const float, WS_X); float* out = OUTP();
        for (int m = gw; m < SEQ; m += NGW) rms_row<false>(X + (size_t)m * DM, INP(I_FNG), out + (size_t)m * DM, lane); }
#undef IN
#undef INL
#undef SEAM
}

extern "C" void kernel_launch(void* const* d_in, const int* in_sizes, int n_in, void* d_out, int out_size, void* d_ws, size_t ws_size, hipStream_t stream) {
    static int grid = 0;
    if (grid == 0) {
        if (n_in != N_INPUTS || in_sizes[0] != SEQ * DM || out_size != SEQ * DM || ws_size < WS_END) {
            fprintf(stderr, "kernel_launch: unexpected problem: n_in %d in0 %d out %d ws %zu (need %zu)\n", n_in, n_in > 0 ? in_sizes[0] : -1, out_size, ws_size, (size_t)WS_END); grid = -1; return; }
        int dev = 0, cus = 0;
        if (hipGetDevice(&dev) != hipSuccess || hipDeviceGetAttribute(&cus, hipDeviceAttributeMultiprocessorCount, dev) != hipSuccess) { grid = -1; return; }
        if (hipFuncSetAttribute((const void*)mk_fwd, hipFuncAttributeMaxDynamicSharedMemorySize, LDS_BYTES) != hipSuccess) { fprintf(stderr, "kernel_launch: hipFuncSetAttribute failed\n"); grid = -1; return; }
        int per_cu = 0;
        if (hipOccupancyMaxActiveBlocksPerMultiprocessor(&per_cu, (const void*)mk_fwd, 512, LDS_BYTES) != hipSuccess || per_cu < 1) fprintf(stderr, "kernel_launch: occupancy query reports %d\n", per_cu);
        (void)hipGetLastError();
        grid = cus;
    }
    if (grid < 0) return;
    if (hipMemsetAsync((char*)d_ws + WS_CTL, 0, CTL_ZERO_BYTES, stream) != hipSuccess) return;
    Args a{};
    for (int i = 0; i < N_INPUTS; ++i) a.in[i] = (const float*)d_in[i];
    a.out = (float*)d_out; a.ws = (unsigned char*)d_ws; a.pad = 0;
#if MK_ONE_LAUNCH
    a.ph_lo = 0; a.ph_hi = PH_TOTAL; a.use_bar = 1;
    hipLaunchKernelGGL(mk_fwd, dim3(grid), dim3(512), LDS_BYTES, stream, a);
#else
    for (int p = 0; p < PH_TOTAL; ++p) { a.ph_lo = p; a.ph_hi = p + 1; a.use_bar = 0;
        hipLaunchKernelGGL(mk_fwd, dim3(grid), dim3(512), LDS_BYTES, stream, a); }
#endif
}
```

```cpp
#include <hip/hip_runtime.h>
#include <cstdio>
#include <cstdint>
namespace pg8 {
#define PG8_LAS __attribute__((address_space(3)))
typedef unsigned short bf16_t;
typedef short bf16x8 __attribute__((ext_vector_type(8)));
typedef float f32x4 __attribute__((ext_vector_type(4)));
typedef unsigned u32x4 __attribute__((ext_vector_type(4)));
constexpr int BM = 256, BK = 64, HALF = 128, HTB = HALF * BK * 2  , STAGE_BYTES = 8 * HTB, NXCD = 8, WGM = 8;

__host__ __device__ __forceinline__ int lds_byte(int r, int c) { const int st = (r >> 4) * 2 + (c >> 5), rr = r & 15, cc = c & 31, ob = rr * 64 + cc * 2; return st * 1024 + (ob ^ (((ob >> 9) & 1) << 5)); }
__host__ __device__ __forceinline__ void stage_rc(int b, int& R, int& C) { const int st = b / 1024, sb = b % 1024, swz = sb ^ (((sb >> 9) & 1) << 5); R = (st >> 1) * 16 + swz / 64; C = (st & 1) * 32 + (swz % 64) / 2; }
__host__ __device__ __forceinline__ int perm32(int rho) { const int n = rho >> 4, i = rho & 15; return 8 * (i >> 2) + 4 * n + (i & 3); }

struct Unit { int pm, pn; };
struct Gemm { const bf16_t* A; const bf16_t* Bt; int M, N, K; };

struct StaticOrder {
    int nM, nN, nwg, G, c;
    __host__ __device__ void init(int M, int N, int G_, int c_) { nM = M / BM; nN = N / BM; nwg = nM * nN; G = G_; c = c_; }
    __host__ __device__ bool next(int i, Unit& u) const {
        const long L = (long)i * G + c; if (L >= nwg) return false;
        int wgid = (int)L; { const int q = nwg / NXCD, r = nwg % NXCD, xcd = wgid % NXCD, off = wgid / NXCD; wgid = (xcd < r ? xcd * (q + 1) : r * (q + 1) + (xcd - r) * q) + off; }
        const int nig = WGM * nN, gid = wgid / nig, fm = gid * WGM, gsz = (nM - fm) < WGM ? (nM - fm) : WGM;
        u.pm = fm + ((wgid % nig) % gsz); u.pn = (wgid % nig) / gsz; return true;
    }
    __device__ __forceinline__ void a_ready(const Unit&) const {}
    __device__ __forceinline__ void done(const Unit&) const {}
};

__device__ __forceinline__ unsigned cvt_pk_bf16(float lo, float hi) { unsigned r; asm volatile("v_cvt_pk_bf16_f32 %0, %1, %2" : "=v"(r) : "v"(lo), "v"(hi)); return r; }
__device__ __forceinline__ float rstd_of(float ssq) { return 1.0f / sqrtf(ssq * (1.0f / 4096.0f) + 1e-5f); }
template <int ACT, int MODE> struct EpiBf16P {
    static constexpr bool PERM = true, AFTER_DRAIN = false;
    bf16_t* O; int ldc; const float* rstd;
    __device__ __forceinline__ void operator()(const f32x4 (&acc)[2][2][4][2], const Unit& u, int wr, int wc, int fr, int fq) const {
        const int row0 = u.pm * BM + wr * 64 + fr, col0 = u.pn * BM + wc * 32 + 8 * fq;
        f32x4 cs[2][2];
        if (MODE == 2) {
#pragma unroll
            for (int bj = 0; bj < 2; ++bj)
#pragma unroll
                for (int n = 0; n < 2; ++n) cs[bj][n] = *(const f32x4*)(rstd + col0 + bj * HALF + 4 * n);
        }
#pragma unroll
        for (int ai = 0; ai < 2; ++ai)
#pragma unroll
            for (int m = 0; m < 4; ++m) { const int row = row0 + ai * HALF + m * 16; bf16_t* rowp = O + (size_t)row * ldc + col0;
                float rs = 1.f; if (MODE == 1) rs = rstd[row];
#pragma unroll
                for (int bj = 0; bj < 2; ++bj) { f32x4 v0 = acc[ai][bj][m][0], v1 = acc[ai][bj][m][1];
                    if (MODE == 1) { v0 = v0 * rs; v1 = v1 * rs; }
                    if (MODE == 2) { v0 = v0 * cs[bj][0]; v1 = v1 * cs[bj][1]; }
                    if (ACT == 1) {
#pragma unroll
                        for (int j = 0; j < 4; ++j) { const float a = fmaxf(v0[j], 0.f), b = fmaxf(v1[j], 0.f); v0[j] = a * a; v1[j] = b * b; } }
                    u32x4 w; w.x = cvt_pk_bf16(v0[0], v0[1]); w.y = cvt_pk_bf16(v0[2], v0[3]); w.z = cvt_pk_bf16(v1[0], v1[1]); w.w = cvt_pk_bf16(v1[2], v1[3]);
                    *(u32x4*)(rowp + bj * HALF) = w; } }
    }
};
struct EpiRes {
    static constexpr bool PERM = false, AFTER_DRAIN = false;
    const float* base; float* out; bf16_t* xb; float* part; int ldc, nrows;
    __device__ __forceinline__ void operator()(const f32x4 (&acc)[2][2][4][2], const Unit& u, int wr, int wc, int fr, int fq) const {
        typedef unsigned u32x2 __attribute__((ext_vector_type(2)));
        const int row0 = u.pm * BM + wr * 64 + fr, col0 = u.pn * BM + wc * 32 + 4 * fq;
#pragma unroll
        for (int ai = 0; ai < 2; ++ai)
#pragma unroll
            for (int m = 0; m < 4; ++m) { const int row = row0 + ai * HALF + m * 16; const size_t off = (size_t)row * ldc + col0;
                float sq = 0.f;
#pragma unroll
                for (int bj = 0; bj < 2; ++bj)
#pragma unroll
                    for (int n = 0; n < 2; ++n) { const f32x4 bs = *(const f32x4*)(base + off + bj * HALF + n * 16); const f32x4 o = bs + acc[ai][bj][m][n];
                        *(f32x4*)(out + off + bj * HALF + n * 16) = o;
                        u32x2 w; w.x = cvt_pk_bf16(o[0], o[1]); w.y = cvt_pk_bf16(o[2], o[3]); *(u32x2*)(xb + off + bj * HALF + n * 16) = w;
                        sq += (o[0] * o[0] + o[1] * o[1]) + (o[2] * o[2] + o[3] * o[3]); }
                sq += __shfl_xor(sq, 16); sq += __shfl_xor(sq, 32);
                if (fq == 0) part[(size_t)(4 * u.pn + wc) * nrows + row] = sq;
                asm volatile("" ::: "memory"); }
    }
};

template <class Epi, class Sched, bool ALIGN_EPI = false, bool SP2 = false>
__device__ __forceinline__ void gemm_phase(PG8_LAS unsigned char* lds, const Gemm g, const Sched& S, const Epi& E, int tid_arg) {
    int tid_ = tid_arg; asm volatile("" : "+v"(tid_));
    const int tid = tid_, wid = __builtin_amdgcn_readfirstlane(tid >> 6), lane = tid & 63, wr = wid >> 2, wc = wid & 3, fr = lane & 15, fq = lane >> 4;
    const int K = g.K, nt = K / BK;
    unsigned voffA[2], voffB[2];
#pragma unroll
    for (int i = 0; i < 2; ++i) { int R, C; stage_rc(tid * 16 + i * 8192, R, C); const int Rb = Epi::PERM ? ((R & ~31) + perm32(R & 31)) : R;
        voffA[i] = (unsigned)(R * K + C) * 2u; voffB[i] = (unsigned)(Rb * K + C) * 2u; }
    const size_t kstep = (size_t)(BK * 2);
    const size_t hstep = (size_t)HALF * K * 2;
    const size_t tstep = 2 * hstep;
    const unsigned ldsw = (unsigned)wid * 1024u;
    const int aoff = lds_byte(wr * 64 + fr, fq * 8), boff = lds_byte(wc * 32 + fr, fq * 8);
#define PG8_SA(b, h) (((b) * 2 + (h)) * HTB)
#define PG8_SB(b, h) ((4 + (b) * 2 + (h)) * HTB)
#define PG8_STAGE(bufoff, gbase, voff) do { _Pragma("unroll") for (int _i = 0; _i < 2; ++_i) \
        __builtin_amdgcn_global_load_lds((const unsigned*)((const char*)(gbase) + (voff)[_i]), (PG8_LAS unsigned*)(lds + (bufoff) + ldsw + _i * 8192), 16, 0, 0); } while (0)
#define PG8_LDA(dst, b, h) do { _Pragma("unroll") for (int m = 0; m < 4; ++m) _Pragma("unroll") for (int k = 0; k < 2; ++k) dst[m][k] = *(const PG8_LAS bf16x8*)(lds + PG8_SA(b, h) + aoff + m * 2048 + k * 1024); } while (0)
#define PG8_LDB(dst, b, h) do { _Pragma("unroll") for (int n = 0; n < 2; ++n) _Pragma("unroll") for (int k = 0; k < 2; ++k) dst[n][k] = *(const PG8_LAS bf16x8*)(lds + PG8_SB(b, h) + boff + n * 2048 + k * 1024); } while (0)
#define PG8_MMA(ai, bj, At, Bt) do { __builtin_amdgcn_s_setprio(1); _Pragma("unroll") for (int m = 0; m < 4; ++m) _Pragma("unroll") for (int n = 0; n < 2; ++n) _Pragma("unroll") for (int k = 0; k < 2; ++k) \
        acc[ai][bj][m][n] = __builtin_amdgcn_mfma_f32_16x16x32_bf16(Bt[n][k], At[m][k], acc[ai][bj][m][n], 0, 0, 0); __builtin_amdgcn_s_setprio(0); } while (0)
#define PG8_WAIT_V(n) asm volatile("s_waitcnt vmcnt(" #n ")" ::: "memory")
#define PG8_WAIT_L(n) asm volatile("s_waitcnt lgkmcnt(" #n ")" ::: "memory")
#define PG8_BAR __builtin_amdgcn_s_barrier()
#define PG8_SCHED __builtin_amdgcn_sched_barrier(0)
    Unit cur, nxt; int ui = 0;
    if (!S.next(0, cur)) return;
    f32x4 acc[2][2][4][2];
#pragma unroll
    for (int a = 0; a < 2; ++a)
#pragma unroll
        for (int b = 0; b < 2; ++b)
#pragma unroll
            for (int m = 0; m < 4; ++m)
#pragma unroll
                for (int n = 0; n < 2; ++n) acc[a][b][m][n] = (f32x4){0.f, 0.f, 0.f, 0.f};
    bf16x8 At[4][2], B0[2][2], B1[2][2];
    const char* cA = (const char*)g.A + (size_t)cur.pm * tstep; const char* cB = (const char*)g.Bt + (size_t)cur.pn * tstep;
    S.a_ready(cur);
    if constexpr (SP2) {
        PG8_STAGE(PG8_SB(0, 0), cB, voffB); PG8_STAGE(PG8_SB(0, 1), cB + hstep, voffB); PG8_STAGE(PG8_SA(0, 0), cA, voffA); PG8_STAGE(PG8_SA(0, 1), cA + hstep, voffA);
        if (wr == 1) PG8_BAR;
        PG8_WAIT_V(2); PG8_BAR;
        PG8_STAGE(PG8_SB(1, 0), cB + kstep, voffB); PG8_STAGE(PG8_SA(1, 0), cA + kstep, voffA); PG8_STAGE(PG8_SB(1, 1), cB + hstep + kstep, voffB);
        PG8_WAIT_V(6); PG8_BAR;
    } else {
        PG8_STAGE(PG8_SB(0, 0), cB, voffB); PG8_STAGE(PG8_SA(0, 0), cA, voffA); PG8_STAGE(PG8_SB(0, 1), cB + hstep, voffB); PG8_STAGE(PG8_SA(0, 1), cA + hstep, voffA);
        if (wr == 1) PG8_BAR;
        PG8_WAIT_V(4); PG8_BAR;
        PG8_STAGE(PG8_SB(1, 0), cB + kstep, voffB); PG8_STAGE(PG8_SA(1, 0), cA + kstep, voffA); PG8_STAGE(PG8_SB(1, 1), cB + hstep + kstep, voffB);
        PG8_WAIT_V(6); PG8_BAR;
    }
    for (;;) {
        const bool has_next = S.next(ui + 1, nxt);
        const char* nA = has_next ? (const char*)g.A + (size_t)nxt.pm * tstep : cA; const char* nB = has_next ? (const char*)g.Bt + (size_t)nxt.pn * tstep : cB;
        for (int t = 0; t < nt; t += 2) {
            const bool last = (t == nt - 2);
            const char* a1 = cA + (size_t)(t + 1) * kstep;
            const char* a2 = last ? nA : cA + (size_t)(t + 2) * kstep; const char* b2 = last ? nB : cB + (size_t)(t + 2) * kstep;
            const char* a3 = a2 + kstep; const char* b3 = b2 + kstep;
            if (last && has_next) S.a_ready(nxt);
            if constexpr (SP2) {
            PG8_LDB(B0, 0, 0); PG8_LDB(B1, 0, 1); PG8_SCHED; PG8_LDA(At, 0, 0); PG8_STAGE(PG8_SA(1, 1), a1 + hstep, voffA);
            PG8_WAIT_V(8); PG8_WAIT_L(0); PG8_BAR; PG8_MMA(0, 0, At, B0); PG8_MMA(0, 1, At, B1); PG8_BAR; PG8_SCHED;
            PG8_LDA(At, 0, 1); PG8_STAGE(PG8_SB(0, 0), b2, voffB); PG8_STAGE(PG8_SB(0, 1), b2 + hstep, voffB); PG8_STAGE(PG8_SA(0, 0), a2, voffA);
            PG8_WAIT_V(8); PG8_WAIT_L(0); PG8_BAR; PG8_MMA(1, 0, At, B0); PG8_MMA(1, 1, At, B1); PG8_BAR; PG8_SCHED;
            PG8_LDB(B0, 1, 0); PG8_LDB(B1, 1, 1); PG8_SCHED; PG8_LDA(At, 1, 0); PG8_STAGE(PG8_SA(0, 1), a2 + hstep, voffA);
            PG8_WAIT_V(8); PG8_WAIT_L(0); PG8_BAR; PG8_MMA(0, 0, At, B0); PG8_MMA(0, 1, At, B1); PG8_BAR; PG8_SCHED;
            PG8_LDA(At, 1, 1); PG8_STAGE(PG8_SB(1, 0), b3, voffB); PG8_STAGE(PG8_SB(1, 1), b3 + hstep, voffB); PG8_STAGE(PG8_SA(1, 0), a3, voffA);
            PG8_WAIT_V(8); PG8_WAIT_L(0); PG8_BAR; PG8_MMA(1, 0, At, B0); PG8_MMA(1, 1, At, B1); PG8_BAR; PG8_SCHED;
            } else {
            PG8_LDB(B0, 0, 0); PG8_SCHED; PG8_LDA(At, 0, 0); PG8_STAGE(PG8_SA(1, 1), a1 + hstep, voffA);
            PG8_WAIT_L(8); PG8_BAR; PG8_WAIT_L(0); PG8_MMA(0, 0, At, B0); PG8_BAR; PG8_SCHED;
            PG8_LDB(B1, 0, 1); PG8_STAGE(PG8_SB(0, 0), b2, voffB);
            PG8_BAR; PG8_WAIT_L(0); PG8_MMA(0, 1, At, B1); PG8_BAR;
            PG8_LDA(At, 0, 1); PG8_STAGE(PG8_SA(0, 0), a2, voffA);
            PG8_BAR; PG8_WAIT_L(0); PG8_MMA(1, 0, At, B0); PG8_BAR; PG8_SCHED;
            PG8_STAGE(PG8_SB(0, 1), b2 + hstep, voffB);
            PG8_WAIT_V(6); PG8_BAR; PG8_MMA(1, 1, At, B1); PG8_BAR;
            PG8_LDB(B0, 1, 0); PG8_SCHED; PG8_LDA(At, 1, 0); PG8_STAGE(PG8_SA(0, 1), a2 + hstep, voffA);
            PG8_WAIT_L(8); PG8_BAR; PG8_WAIT_L(0); PG8_MMA(0, 0, At, B0); PG8_BAR; PG8_SCHED;
            PG8_LDB(B1, 1, 1); PG8_STAGE(PG8_SB(1, 0), b3, voffB);
            PG8_BAR; PG8_WAIT_L(0); PG8_MMA(0, 1, At, B1); PG8_BAR;
            PG8_LDA(At, 1, 1); PG8_STAGE(PG8_SA(1, 0), a3, voffA);
            PG8_BAR; PG8_WAIT_L(0); PG8_MMA(1, 0, At, B0); PG8_BAR; PG8_SCHED;
            PG8_STAGE(PG8_SB(1, 1), b3 + hstep, voffB);
            PG8_WAIT_V(6); PG8_BAR; PG8_MMA(1, 1, At, B1); PG8_BAR;
            }
        }
        if constexpr (ALIGN_EPI) { if (wr == 0) PG8_BAR; }
        if constexpr (!Epi::AFTER_DRAIN) { E(acc, cur, wr, wc, fr, fq); S.done(cur); }
        if (!has_next) break;
#pragma unroll
        for (int a = 0; a < 2; ++a)
#pragma unroll
            for (int b = 0; b < 2; ++b)
#pragma unroll
                for (int m = 0; m < 4; ++m)
#pragma unroll
                    for (int n = 0; n < 2; ++n) acc[a][b][m][n] = (f32x4){0.f, 0.f, 0.f, 0.f};
        cur = nxt; cA = nA; cB = nB; ++ui;
        if constexpr (ALIGN_EPI) { if (wr == 1) PG8_BAR; }
    }
    PG8_WAIT_V(0);
    if constexpr (!ALIGN_EPI) { if (wr == 0) PG8_BAR; }
    PG8_BAR;
    if constexpr (Epi::AFTER_DRAIN) { E.fused(acc, cur, wr, wc, fr, fq, lds, wid, lane); S.done(cur); }
#undef PG8_SA
#undef PG8_SB
#undef PG8_STAGE
#undef PG8_LDA
#undef PG8_LDB
#undef PG8_MMA
#undef PG8_WAIT_V
#undef PG8_WAIT_L
#undef PG8_BAR
#undef PG8_SCHED
}
}

constexpr int SEQ = 16384, DM = 4096, DEPTH = 4, HYW = 2048, SSW = 2048, NHEAD = 32, HDIM = 64, NGRP = 8, NST = 128, QCH = 256, NCH = SEQ / QCH;
constexpr int NIN = 12320, DFF = 16384, XBCW = 4096, PSW = 6144, NTAP = 8192;
constexpr float EPS = 1e-5f;
enum { I_X = 0, I_NMG, I_WIN, I_HCW, I_HCB, I_PW1, I_PB1, I_PW2, I_PB2, I_PW3, I_PB3, I_SF, I_WOUTF, I_SKIP, I_HOG, I_SCW, I_SCB, I_ALOG, I_DTB, I_SD, I_SOG, I_WO, I_NLG, I_WUP, I_WDN, I_FNG, N_INPUTS };

constexpr size_t MiB = 1u << 20;
constexpr size_t WS_CTL = 0, CTL_ZERO_BYTES = 1 * MiB;
constexpr size_t WS_TW = 1 * MiB;
constexpr size_t WS_PW = WS_TW + 131072;
constexpr size_t WS_WIN = 2 * MiB;
constexpr size_t WS_WOUT = 100 * MiB;
constexpr size_t WS_WUP = 132 * MiB;
constexpr size_t WS_WDN = 260 * MiB;
constexpr size_t WS_XN = 388 * MiB;
constexpr size_t WS_PT = 516 * MiB;
constexpr size_t WS_PS = 708 * MiB;
constexpr size_t WS_XBC = 900 * MiB;
constexpr size_t WS_H3 = 1028 * MiB;
constexpr size_t WS_DTF = 1032 * MiB, WS_DTB = 1034 * MiB, WS_ACS = 1036 * MiB, WS_RB = 1038 * MiB, WS_SSQ = 1040 * MiB, WS_DTRAW = 1042 * MiB;
constexpr size_t WS_SSQA = 1028 * MiB + 2 * MiB, WS_SSQB = WS_SSQA + 65536;
constexpr size_t WS_PARTA = 2900 * MiB, WS_PARTB = 2904 * MiB;
constexpr size_t WS_HT = 1044 * MiB;
constexpr size_t WS_Z2T = 1556 * MiB;
constexpr size_t WS_S = 1684 * MiB;
constexpr size_t WS_SIN = 1812 * MiB;
constexpr size_t WS_YMIX = 1876 * MiB;
constexpr size_t WS_X = 2004 * MiB;
constexpr size_t WS_H = 2260 * MiB;
constexpr size_t WS_GSCR = 2772 * MiB;
constexpr size_t GSCR_PER_WG = 17 * 512 * 16 + 16 * 512 * 8;
constexpr size_t WS_END = 2908 * MiB;
constexpr int CW_BAR = 4096;

constexpr int LDS_BYTES = 163840;
constexpr int MISC_OFF = LDS_BYTES - 256;
constexpr int FFT_BYTES = (16384 + 512) * 8;
constexpr int RED_OFF = FFT_BYTES;

#define GAS __attribute__((address_space(1)))
#define LAS __attribute__((address_space(3)))
typedef unsigned short bf16;
typedef unsigned v4u __attribute__((ext_vector_type(4)));
typedef unsigned v2u __attribute__((ext_vector_type(2)));
typedef float f32x4 __attribute__((ext_vector_type(4)));
typedef float f32x2 __attribute__((ext_vector_type(2)));
typedef float f32x16 __attribute__((ext_vector_type(16)));
typedef short bf16x8 __attribute__((ext_vector_type(8)));
typedef short bf16x4 __attribute__((ext_vector_type(4)));
#define LDS_WAIT() asm volatile("s_waitcnt lgkmcnt(0)" ::: "memory")
__device__ __forceinline__ float bf2f(unsigned short h) { return __uint_as_float((unsigned)h << 16); }
__device__ __forceinline__ float bflo(unsigned w) { return __uint_as_float(w << 16); }
__device__ __forceinline__ float bfhi(unsigned w) { return __uint_as_float(w & 0xffff0000u); }
__device__ __forceinline__ unsigned pk2(float lo, float hi) { return pg8::cvt_pk_bf16(lo, hi); }
__device__ __forceinline__ float wave_sum(float v) {
#pragma unroll
    for (int o = 1; o < 64; o <<= 1) v += __shfl_xor(v, o);
    return v;
}
__device__ __forceinline__ float rdlane(float v, int l) { return __int_as_float(__builtin_amdgcn_readlane(__float_as_int(v), l)); }
__device__ __forceinline__ float silu_f(float x) { return x / (1.0f + __expf(-x)); }
__device__ __forceinline__ float softplus_f(float x) { return fmaxf(x, 0.f) + log1pf(expf(-fabsf(x))); }

#define XB_TMO      128
#define XB_XCNT(j)  (256  + 64 * (j))
#define XB_XSUB(j)  (1280 + 64 * (j))
#define XB_XGEN(j)  (2304 + 64 * (j))
#define XB_TOP      3328
#define XB_TOPGEN   3392
#define XCD_BAR_WORDS 3456
#define XB_SPIN_CAP (1u << 18)

__device__ __forceinline__ unsigned xb_ld(unsigned* p)              { return __hip_atomic_load(p, __ATOMIC_RELAXED, __HIP_MEMORY_SCOPE_AGENT); }
__device__ __forceinline__ unsigned xb_add(unsigned* p, unsigned v) { return __hip_atomic_fetch_add(p, v, __ATOMIC_RELAXED, __HIP_MEMORY_SCOPE_AGENT); }
__device__ __forceinline__ unsigned xb_xcc_id() { return (unsigned)__builtin_amdgcn_s_getreg((3 << 11) | 20) & 0xFu; }
#define XB_SPIN(cond, bar) do { unsigned _sp = 0; while (cond) { __builtin_amdgcn_s_sleep(1); \
    if ((++_sp & 255u) == 0u) { if (xb_ld(&(bar)[XB_TMO])) break; if (_sp > XB_SPIN_CAP) { atomicAdd(&(bar)[XB_TMO], 1u); break; } } } } while (0)

struct XcdBarrier {
    unsigned* bar; unsigned x;
    volatile LAS unsigned* st;
};

__device__ __forceinline__ XcdBarrier xcd_barrier_post(unsigned* bar, volatile LAS unsigned* st) {
    XcdBarrier b; b.bar = bar; b.x = xb_xcc_id(); b.st = st;
    if (threadIdx.x == 0) (void)xb_add(&bar[XB_XCNT(b.x)], 1u);
    return b;
}
__device__ __forceinline__ void xcd_barrier_complete(unsigned* bar, unsigned x, unsigned& nloc, unsigned& nx) {
    const unsigned G = gridDim.x * gridDim.y * gridDim.z;
    unsigned sum, cnt, mine, sp = 0u;
    for (;;) {
        sum = 0u; cnt = 0u; mine = 0u;
#pragma unroll
        for (unsigned j = 0; j < 16; ++j) { const unsigned c = xb_ld(&bar[XB_XCNT(j)]); sum += c; cnt += (c > 0u) ? 1u : 0u; mine = (j == x) ? c : mine; }
        if (sum == G) break;
        __builtin_amdgcn_s_sleep(1);
        if ((++sp & 255u) == 0u) { if (xb_ld(&bar[XB_TMO])) break; if (sp > XB_SPIN_CAP) { atomicAdd(&bar[XB_TMO], 1u); break; } }
    }
    nloc = mine > 0u ? mine : 1u; nx = cnt > 0u ? cnt : 1u;
}

__device__ __forceinline__ void xcd_barrier(const XcdBarrier& b) {
    asm volatile("s_waitcnt vmcnt(0)" ::: "memory");
    __syncthreads();
    if (threadIdx.x == 0) {
        unsigned* bar = b.bar;
        __builtin_amdgcn_s_waitcnt(0);
        unsigned nloc = b.st[0], nx = b.st[1];
        if (nloc == 0u) { xcd_barrier_complete(bar, b.x, nloc, nx); b.st[0] = nloc; b.st[1] = nx; }
        const unsigned old = xb_add(&bar[XB_XSUB(b.x)], 1u);
        const unsigned gen = old / nloc;
        if (old + 1u == (gen + 1u) * nloc) {
            __builtin_amdgcn_fence(__ATOMIC_RELEASE, "agent");
            asm volatile("s_waitcnt vmcnt(0)" ::: "memory");
            const unsigned og = xb_add(&bar[XB_TOP], 1u);
            const unsigned tg = og / nx;
            if (og + 1u == (tg + 1u) * nx) xb_add(&bar[XB_TOPGEN], 1u);
            else XB_SPIN(xb_ld(&bar[XB_TOPGEN]) == tg, bar);
            __builtin_amdgcn_fence(__ATOMIC_ACQUIRE, "agent");
            xb_add(&bar[XB_XGEN(b.x)], 1u);
            asm volatile("s_waitcnt vmcnt(0)" ::: "memory");
        } else {
            XB_SPIN(xb_ld(&bar[XB_XGEN(b.x)]) == gen, bar);
            __builtin_amdgcn_fence(__ATOMIC_ACQUIRE, "agent");
            asm volatile("s_waitcnt vmcnt(0)" ::: "memory");
        }
    }
    __syncthreads();
}

__device__ __forceinline__ void transpose_item(const float* W, int K, int N, bf16* WT, LAS float* scr, int item, int lane, const float* gk) {
    const int nblk = N / 32, kb = item / nblk, nb = item % nblk, k0 = 64 * kb, n0 = 32 * nb;
#pragma unroll 8
    for (int i = 0; i < 32; ++i) { const int kk = 2 * i + (lane >> 5); scr[kk * 33 + (lane & 31)] = W[(size_t)(k0 + kk) * N + n0 + (lane & 31)]; }
    LDS_WAIT(); asm volatile("" ::: "memory");
    const int c = lane & 7;
    f32x4 g0 = (f32x4){1.f, 1.f, 1.f, 1.f}, g1 = g0;
    if (gk) { g0 = *(const f32x4*)(gk + k0 + 8 * c); g1 = *(const f32x4*)(gk + k0 + 8 * c + 4); }
#pragma unroll
    for (int j = 0; j < 4; ++j) { const int n = (lane >> 3) + 8 * j; const LAS float* s = scr + (8 * c) * 33 + n;
        v4u o; o.x = pk2(s[0 * 33] * g0.x, s[1 * 33] * g0.y); o.y = pk2(s[2 * 33] * g0.z, s[3 * 33] * g0.w); o.z = pk2(s[4 * 33] * g1.x, s[5 * 33] * g1.y); o.w = pk2(s[6 * 33] * g1.z, s[7 * 33] * g1.w);
        *(v4u*)(WT + (size_t)(n0 + n) * K + k0 + 8 * c) = o; }
    LDS_WAIT(); asm volatile("" ::: "memory");
}
template <bool TO_BF16>
__device__ __forceinline__ void rms_row(const float* xrow, const float* g, void* orow, int lane) {
    const f32x4* xr = (const f32x4*)xrow + lane;
    f32x4 v[16]; float s = 0.f;
#pragma unroll
    for (int j = 0; j < 16; ++j) { v[j] = xr[64 * j]; s += (v[j].x * v[j].x + v[j].y * v[j].y) + (v[j].z * v[j].z + v[j].w * v[j].w); }
    const float r = 1.0f / sqrtf(wave_sum(s) * (1.f / DM) + EPS);
    const f32x4* gr = (const f32x4*)g + lane;
#pragma unroll
    for (int j = 0; j < 16; ++j) { const f32x4 gg = gr[64 * j]; const f32x4 o = v[j] * r * gg;
        if (TO_BF16) { v2u w; w.x = pk2(o.x, o.y); w.y = pk2(o.z, o.w); ((v2u*)orow)[lane + 64 * j] = w; }
        else ((f32x4*)orow)[lane + 64 * j] = o; }
}
__device__ __forceinline__ void rstd_reduce(const float* part, float* rstd, int row) {
    float s = 0.f;
#pragma unroll 16
    for (int j = 0; j < 64; ++j) s += part[(size_t)j * SEQ + row];
    rstd[row] = pg8::rstd_of(s);
}
__device__ __forceinline__ void prep_row(const float* xrow, bf16* orow, float* rstd, int lane) {
    const f32x4* xr = (const f32x4*)xrow + lane; float s = 0.f;
#pragma unroll
    for (int j = 0; j < 16; ++j) { const f32x4 v = xr[64 * j]; s += (v.x * v.x + v.y * v.y) + (v.z * v.z + v.w * v.w); v2u w; w.x = pk2(v.x, v.y); w.y = pk2(v.z, v.w); ((v2u*)orow)[lane + 64 * j] = w; }
    s = wave_sum(s);
    if (lane == 0) *rstd = pg8::rstd_of(s);
}
__device__ __forceinline__ void posmlp_row(int t, const float* w1, const float* b1, const float* w2, const float* b2, const float* w3, const float* b3, const float* sf, bf16* h3row, int lane) {
    const float tl = (float)t / 16383.0f;
    const float wang = (6.283185307179586f * (float)t) / 16384.0f;
    float zf = 0.f;
    if (lane == 0) zf = tl;
    else if (lane <= 32) { const int i = (lane - 1) & 15; const float sfr = (float)i / 15.0f; const float f = 1e-4f * (1.0f - sfr) + 15.0f * sfr; const float ang = f * wang; zf = (lane <= 16) ? cosf(ang) : -sinf(ang); }
    float acc = b1[lane];
#pragma unroll 11
    for (int f = 0; f < 33; ++f) acc += rdlane(zf, f) * w1[f * 64 + lane];
    float h = sinf(sf[lane] * acc);
    acc = b2[lane];
#pragma unroll 8
    for (int i = 0; i < 64; ++i) acc += rdlane(h, i) * w2[i * 64 + lane];
    h = sinf(sf[64 + lane] * acc);
    acc = b3[lane];
#pragma unroll 8
    for (int i = 0; i < 64; ++i) acc += rdlane(h, i) * w3[i * 64 + lane];
    h = sinf(sf[128 + lane] * acc);
    h3row[lane] = (bf16)(pk2(h, h) & 0xffffu);
}
__device__ __forceinline__ f32x4 mfma16_t(bf16x8 a, bf16x8 b, f32x4 c) { return __builtin_amdgcn_mfma_f32_16x16x32_bf16(a, b, c, 0, 0, 0); }
__device__ __forceinline__ void taps_gemm(const float* wout, const bf16* h3, bf16* HT, int gw, int NGW, int lane) {
    const int g = lane >> 4, li = lane & 15;
    const int ngroups = NGW / 256;
    if (ngroups == 0) return;
    const int nblk = gw % 256, tg = gw / 256;
    if (tg >= ngroups) return;
    const int n0 = 32 * nblk, steps_per = (SEQ / 16) / ngroups;
    const bool bwd = ((n0 >> 11) & 1) != 0;
    bf16x8 wf[2][2];
#pragma unroll
    for (int nt = 0; nt < 2; ++nt)
#pragma unroll
        for (int ks = 0; ks < 2; ++ks) { float w[8];
#pragma unroll
            for (int j = 0; j < 8; ++j) w[j] = wout[(size_t)(32 * ks + 8 * g + j) * NTAP + n0 + 16 * nt + li];
            v4u p; p.x = pk2(w[0], w[1]); p.y = pk2(w[2], w[3]); p.z = pk2(w[4], w[5]); p.w = pk2(w[6], w[7]); wf[nt][ks] = __builtin_bit_cast(bf16x8, p); }
    float ad[2];
#pragma unroll
    for (int nt = 0; nt < 2; ++nt) { const int c = (n0 + 16 * nt + li) & 2047; const float sfr = (float)c / 2047.0f;
        ad[nt] = fabsf(-120.39728043259361f * (1.0f - sfr) + 40.546510810816436f * sfr); }
    const int off = bwd ? 1 : 0;
#pragma unroll 2
    for (int i = 0; i < steps_per; ++i) {
        const int t0 = 16 * (tg * steps_per + i);
        const int trow = t0 + li + off;
        bf16x8 a0 = (bf16x8){0, 0, 0, 0, 0, 0, 0, 0}, a1 = a0;
        if (trow < SEQ) { const bf16x8* hr = (const bf16x8*)(h3 + (size_t)trow * 64 + 8 * g); a0 = hr[0]; a1 = hr[4]; }
        const float tl0 = (float)(t0 + off + 4 * g) / 16383.0f;
#pragma unroll
        for (int nt = 0; nt < 2; ++nt) {
            f32x4 d = (f32x4){0.f, 0.f, 0.f, 0.f};
            d = mfma16_t(a0, wf[nt][0], d); d = mfma16_t(a1, wf[nt][1], d);
            float v[4];
#pragma unroll
            for (int r = 0; r < 4; ++r) v[r] = d[r] * __expf(-(tl0 + (float)r / 16383.0f) * ad[nt]);
            bf16* rowp = HT + (size_t)(n0 + 16 * nt + li) * SEQ;
            v2u o;
            if (!bwd) { o.x = pk2(v[0], v[1]); o.y = pk2(v[2], v[3]); *(v2u*)(rowp + t0 + 4 * g) = o; }
            else { if (t0 + 4 * g + 4 == SEQ) v[3] = 0.f;
                   o.x = pk2(v[3], v[2]); o.y = pk2(v[1], v[0]); *(v2u*)(rowp + (SEQ - t0 - 4 * g - 4)) = o; }
        }
    }
}

#define CMULV(xr, xi, br, bi) do { const float _t = (xr) * (br) - (xi) * (bi); (xi) = (xr) * (bi) + (xi) * (br); (xr) = _t; } while (0)
#define DFT4V(r0, i0, r1, i1, r2, i2, r3, i3) do { \
    const f32x2 t0r = (r0) + (r2), t0i = (i0) + (i2), t1r = (r0) - (r2), t1i = (i0) - (i2); \
    const f32x2 t2r = (r1) + (r3), t2i = (i1) + (i3), dr = (r1) - (r3), di = (i1) - (i3); \
    (r0) = t0r + t2r; (i0) = t0i + t2i; (r2) = t0r - t2r; (i2) = t0i - t2i; \
    (r1) = t1r + di; (i1) = t1i - dr; (r3) = t1r - di; (i3) = t1i + dr; } while (0)
#define CMULVV(xr, xi, br, bi) do { const f32x2 _t = (xr) * (br) - (xi) * (bi); (xi) = (xr) * (bi) + (xi) * (br); (xr) = _t; } while (0)
__device__ __forceinline__ void dft16(f32x2 (&ar)[16], f32x2 (&ai)[16]) {
    const float C1 = 0.92387953251128674f, S1 = 0.38268343236508977f, HH = 0.70710678118654752f;
#pragma unroll
    for (int n2 = 0; n2 < 4; ++n2) DFT4V(ar[n2], ai[n2], ar[4 + n2], ai[4 + n2], ar[8 + n2], ai[8 + n2], ar[12 + n2], ai[12 + n2]);
    CMULVV(ar[5], ai[5], C1, -S1);
    CMULVV(ar[9], ai[9], HH, -HH);
    CMULVV(ar[13], ai[13], S1, -C1);
    CMULVV(ar[6], ai[6], HH, -HH);
    { const f32x2 t = ar[10]; ar[10] = ai[10]; ai[10] = -t; }
    CMULVV(ar[14], ai[14], -HH, -HH);
    CMULVV(ar[7], ai[7], S1, -C1);
    CMULVV(ar[11], ai[11], -HH, -HH);
    CMULVV(ar[15], ai[15], -C1, S1);
#pragma unroll
    for (int k1 = 0; k1 < 4; ++k1) DFT4V(ar[4 * k1], ai[4 * k1], ar[4 * k1 + 1], ai[4 * k1 + 1], ar[4 * k1 + 2], ai[4 * k1 + 2], ar[4 * k1 + 3], ai[4 * k1 + 3]);
}
#define CMULT(xr, xi, br, bi) do { const auto _t = (xr) * (br) - (xi) * (bi); (xi) = (xr) * (bi) + (xi) * (br); (xr) = _t; } while (0)
template <class T>
__device__ __forceinline__ void twiddle16(f32x2 (&ar)[16], f32x2 (&ai)[16], T wr, T wi) {
    const T w2r = wr * wr - wi * wi, w2i = 2.f * wr * wi;
    const T w3r = w2r * wr - w2i * wi, w3i = w2r * wi + w2i * wr;
    const T w4r = w2r * w2r - w2i * w2i, w4i = 2.f * w2r * w2i;
    CMULT(ar[1], ai[1], wr, wi); CMULT(ar[2], ai[2], w2r, w2i); CMULT(ar[3], ai[3], w3r, w3i);
    T br = w4r, bi = w4i;
#pragma unroll
    for (int m = 1; m < 4; ++m) {
        CMULT(ar[4 * m], ai[4 * m], br, bi);
        { T tr = br, ti = bi; CMULT(tr, ti, wr, wi); CMULT(ar[4 * m + 1], ai[4 * m + 1], tr, ti); }
        { T tr = br, ti = bi; CMULT(tr, ti, w2r, w2i); CMULT(ar[4 * m + 2], ai[4 * m + 2], tr, ti); }
        { T tr = br, ti = bi; CMULT(tr, ti, w3r, w3i); CMULT(ar[4 * m + 3], ai[4 * m + 3], tr, ti); }
        CMULT(br, bi, w4r, w4i);
    }
}
constexpr int TWL_OFF = RED_OFF + 256;
__device__ __forceinline__ void fft_fill_twl(const f32x2* TW, const f32x2* PW, LAS unsigned char* lds, int tid) {
    LAS f32x2* twl = (LAS f32x2*)(lds + TWL_OFF);
    twl[tid] = PW[tid]; twl[512 + tid] = TW[16 * (tid & 31)]; twl[1024 + tid] = TW[tid];
}
__device__ __forceinline__ void radix32_combine(const f32x2 (&Dr)[16], const f32x2 (&Di)[16], f32x2 (&X)[32]) {
#pragma unroll
    for (int k = 0; k < 16; ++k) { const int s = 4 * (k & 3) + (k >> 2);
        const float cr = __builtin_cosf(6.28318530717958647692f * (float)k / 32.0f), ci = -__builtin_sinf(6.28318530717958647692f * (float)k / 32.0f);
        const float tr = cr * Dr[s].y - ci * Di[s].y, ti = cr * Di[s].y + ci * Dr[s].y;
        X[k] = (f32x2){Dr[s].x + tr, Di[s].x + ti}; X[k + 16] = (f32x2){Dr[s].x - tr, Di[s].x - ti}; }
}
__device__ __forceinline__ void fft16k(f32x2 (&Rr)[16], f32x2 (&Ri)[16], LAS f32x2* fb, const LAS f32x2* twl, int tid_in) {
    int tid = tid_in; asm volatile("" : "+v"(tid));
    const int j = tid;
    f32x2 X[32];
    __syncthreads();
    dft16(Rr, Ri);
    radix32_combine(Rr, Ri, X);
#pragma unroll
    for (int k = 0; k < 32; ++k) fb[33 * j + k] = X[k];
    __syncthreads();
    {
        const f32x2 w = twl[512 + tid];
#pragma unroll
        for (int s = 0; s < 16; ++s) { const f32x2 v0 = fb[j + (j >> 5) + 528 * (2 * s)], v1 = fb[j + (j >> 5) + 528 * (2 * s + 1)]; Rr[s] = (f32x2){v0.x, v1.x}; Ri[s] = (f32x2){v0.y, v1.y}; }
        const float w2r = w.x * w.x - w.y * w.y, w2i = 2.f * w.x * w.y;
        twiddle16<float>(Rr, Ri, w2r, w2i);
        const f32x2 ur = (f32x2){1.f, w.x}, ui = (f32x2){0.f, w.y};
#pragma unroll
        for (int s = 0; s < 16; ++s) CMULT(Rr[s], Ri[s], ur, ui);
        dft16(Rr, Ri);
        radix32_combine(Rr, Ri, X);
    }
    __syncthreads();
#pragma unroll
    for (int k = 0; k < 32; ++k) fb[(j >> 5) * 1056 + (j & 31) + 33 * k] = X[k];
    __syncthreads();
    {
        const f32x2 w0 = twl[1024 + tid];
        const float c16 = 0.98078528040323043f, s16 = 0.19509032201612825f;
        const f32x2 wr = (f32x2){w0.x, w0.x * c16 + w0.y * s16}, wi = (f32x2){w0.y, w0.y * c16 - w0.x * s16};
#pragma unroll
        for (int r = 0; r < 16; ++r) { const f32x2 v0 = fb[j + (j >> 5) + 1056 * r], v1 = fb[j + (j >> 5) + 528 + 1056 * r]; Rr[r] = (f32x2){v0.x, v1.x}; Ri[r] = (f32x2){v0.y, v1.y}; }
        twiddle16<f32x2>(Rr, Ri, wr, wi);
        dft16(Rr, Ri);
#pragma unroll
        for (int k = 0; k < 16; ++k) { const int s = 4 * (k & 3) + (k >> 2); if (k < s) { const f32x2 tr = Rr[k], ti = Ri[k]; Rr[k] = Rr[s]; Ri[k] = Ri[s]; Rr[s] = tr; Ri[s] = ti; } }
    }
}
typedef unsigned v2u_a4 __attribute__((ext_vector_type(2), aligned(4)));
struct ConvRaw { unsigned lo, hi, nx; };
__device__ __forceinline__ ConvRaw conv_load(const bf16* row, int m) {
    const v2u_a4 v = *(const v2u_a4*)(row + (m > 0 ? 2 * m - 2 : 0));
    ConvRaw r; r.lo = (m > 0) ? v.x : 0u; r.hi = (m > 0) ? v.y : v.x;
    r.nx = (m < SEQ / 2 - 1) ? (unsigned)row[2 * m + 2] : 0u;
    return r;
}
__device__ __forceinline__ void conv_apply(const ConvRaw& r, float w0, float w1, float w2, float b, float& u0, float& u1) {
    const float pm = bfhi(r.lo), p0 = bflo(r.hi), p1 = bfhi(r.hi), pp = __uint_as_float(r.nx << 16);
    u0 = w0 * pm + w1 * p0 + w2 * p1 + b; u1 = w0 * p0 + w1 * p1 + w2 * pp + b;
}
#define FFT_CALL() do { f32x2 Rr_[16], Ri_[16]; \
    _Pragma("unroll") for (int e_ = 0; e_ < 16; ++e_) { Rr_[e_] = (f32x2){re[2 * e_], re[2 * e_ + 1]}; Ri_[e_] = (f32x2){im[2 * e_], im[2 * e_ + 1]}; } \
    fft16k(Rr_, Ri_, fb, TW, tid_in); \
    _Pragma("unroll") for (int e_ = 0; e_ < 16; ++e_) { re[2 * e_] = Rr_[e_].x; re[2 * e_ + 1] = Rr_[e_].y; im[2 * e_] = Ri_[e_].x; im[2 * e_ + 1] = Ri_[e_].y; } } while (0)
__device__ __forceinline__ f32x2 pw_q(f32x2 wt, int q) {
    const float cr = __builtin_cosf(3.14159265358979323846f * (float)q / 32.0f), ci = -__builtin_sinf(3.14159265358979323846f * (float)q / 32.0f);
    return (f32x2){wt.x * cr - wt.y * ci, wt.x * ci + wt.y * cr};
}
__device__ __forceinline__ void hyena_channel(int c, const bf16* PT, const bf16* HT, const float* cw, const float* cb, const float* skip, bf16* Z2T,
                                              f32x4* gscr, LAS unsigned char* lds, int tid_in) {
#define RETID() int tid = tid_in; asm volatile("" : "+v"(tid))
    LAS f32x2* fb = (LAS f32x2*)lds;
    LAS float* red = (LAS float*)(lds + RED_OFF);
    const LAS f32x2* TW = (const LAS f32x2*)(lds + TWL_OFF);
    const int lane = tid_in & 63, wave = tid_in >> 6;
    float sr[16], si[16];
    {
        RETID();
        const int col = 2 * HYW + c; const float w0 = cw[col], w1 = cw[3 * HYW + col], w2 = cw[6 * HYW + col], b = cb[col];
        const bf16* row = PT + (size_t)col * SEQ;
#pragma unroll
        for (int q = 0; q < 16; ++q) { const ConvRaw r = conv_load(row, tid + 512 * q); conv_apply(r, w0, w1, w2, b, sr[q], si[q]); }
    }
#pragma unroll 1
    for (int o = 0; o < 2; ++o) {
        float re[32], im[32];
        float Agr[17], Agi[17], Bgr[17], Bgi[17];
        {
            RETID();
            const bf16* hf = HT + (size_t)(o * 4096 + c) * SEQ;
            const bf16* hb = HT + (size_t)(o * 4096 + 2048 + c) * SEQ;
            float l1 = 0.f;
#pragma unroll
            for (int q = 0; q < 32; ++q) { const int m = tid + 512 * q;
                const unsigned w = (q < 16) ? *(const unsigned*)(hf + 2 * m) : *(const unsigned*)(hb + 2 * m - SEQ);
                re[q] = bflo(w); im[q] = bfhi(w); l1 += fabsf(re[q]) + fabsf(im[q]); }
            l1 = wave_sum(l1);
            __syncthreads();
            if (lane == 0) red[wave] = l1;
            __syncthreads();
            float tot = 0.f;
#pragma unroll
            for (int w = 0; w < 8; ++w) tot += red[w];
            const float scale = 1.0f / (8.0f * (float)SEQ * tot);
            FFT_CALL();
            __syncthreads();
          { RETID();
#pragma unroll
            for (int q = 0; q < 32; ++q) fb[tid + (tid >> 5) + 528 * q] = (f32x2){re[q], im[q]}; }
            __syncthreads();
          { RETID(); const f32x2 wt = TW[tid];
#pragma unroll
            for (int q = 0; q < 17; ++q) {
                const int k = tid + 512 * q;
                if (q < 16 || tid == 0) {
                    const int kp = (SEQ - k) & (SEQ - 1);
                    f32x2 zk; if (q < 16) zk = (f32x2){re[q], im[q]}; else zk = fb[(SEQ / 2) + (SEQ / 64)];
                    const f32x2 zp = fb[kp + (kp >> 5)];
                    const f32x2 w = (q < 16) ? pw_q(wt, q) : (f32x2){0.f, -1.f};
                    const float er = zk.x + zp.x, ei = zk.y - zp.y, orr = zk.y + zp.y, oi = zp.x - zk.x;
                    const float wor = w.x * orr - w.y * oi, woi = w.x * oi + w.y * orr;
                    Agr[q] = (er + wor) * scale; Agi[q] = (ei + woi) * scale; Bgr[q] = (er - wor) * scale; Bgi[q] = (ei - woi) * scale;
                } else { Agr[q] = 0.f; Agi[q] = 0.f; Bgr[q] = 0.f; Bgi[q] = 0.f; }
            } }
        }
#pragma unroll
        for (int q = 0; q < 16; ++q) { re[q] = sr[q]; im[q] = si[q]; re[q + 16] = 0.f; im[q + 16] = 0.f; }
        FFT_CALL();
        __syncthreads();
      { RETID();
#pragma unroll
        for (int q = 0; q < 32; ++q) fb[tid + (tid >> 5) + 528 * q] = (f32x2){re[q], im[q]}; }
        __syncthreads();
      { RETID(); const f32x2 wt = TW[tid];
#pragma unroll
        for (int q = 0; q < 17; ++q) {
            const int k = tid + 512 * q;
            if (q < 16 || tid == 0) {
                const int kp = (SEQ - k) & (SEQ - 1);
                f32x2 zk; if (q < 16) zk = (f32x2){re[q], im[q]}; else zk = fb[(SEQ / 2) + (SEQ / 64)];
                const f32x2 zp = fb[kp + (kp >> 5)];
                const f32x2 w = (q < 16) ? pw_q(wt, q) : (f32x2){0.f, -1.f};
                const float er = zk.x + zp.x, ei = zk.y - zp.y, orr = zk.y + zp.y, oi = zp.x - zk.x;
                const float wor = w.x * orr - w.y * oi, woi = w.x * oi + w.y * orr;
                const float ar = er + wor, ai = ei + woi, br = er - wor, bi = ei - woi;
                const float aar = ar * Agr[q] - ai * Agi[q], aai = ar * Agi[q] + ai * Agr[q];
                const float bbr = br * Bgr[q] - bi * Bgi[q], bbi = br * Bgi[q] + bi * Bgr[q];
                const float eyr = aar + bbr, eyi = aai + bbi, dyr = aar - bbr, dyi = aai - bbi;
                const float oyr = dyr * w.x + dyi * w.y, oyi = dyi * w.x - dyr * w.y;
                if (q < 16) { re[q] = eyr - oyi; im[q] = -eyi - oyr; fb[kp + (kp >> 5)] = (f32x2){eyr + oyi, eyi - oyr}; }
                else fb[(SEQ / 2) + (SEQ / 64)] = (f32x2){eyr - oyi, -eyi - oyr};
            }
        } }
        __syncthreads();
      { RETID();
#pragma unroll
        for (int q = 16; q < 32; ++q) { const f32x2 v = fb[tid + (tid >> 5) + 528 * q]; re[q] = v.x; im[q] = v.y; } }
        ConvRaw graw[16];
      { RETID(); const bf16* grow = PT + (size_t)(o * HYW + c) * SEQ;
#pragma unroll
        for (int q = 0; q < 16; ++q) graw[q] = conv_load(grow, tid + 512 * q); }
        FFT_CALL();
        {
            RETID();
            const int col = o * HYW + c; const float w0 = cw[col], w1 = cw[3 * HYW + col], w2 = cw[6 * HYW + col], b = cb[col];
            const float sk = skip[o * HYW + c]; bf16* orow = Z2T + (size_t)c * SEQ;
#pragma unroll
            for (int q = 0; q < 16; ++q) { float g0, g1; conv_apply(graw[q], w0, w1, w2, b, g0, g1);
                const float o0 = g0 * (re[q] + sk * sr[q]), o1 = g1 * (-im[q] + sk * si[q]);
                sr[q] = o0; si[q] = o1;
                if (o == 1) *(unsigned*)(orow + 2 * (tid + 512 * q)) = pk2(o0, o1); }
        }
    }
#undef RETID
}

typedef unsigned short u16;
__device__ __forceinline__ f32x4 mfma16(bf16x8 a, bf16x8 b, f32x4 c) { return __builtin_amdgcn_mfma_f32_16x16x32_bf16(a, b, c, 0, 0, 0); }

__device__ __forceinline__ void ssm_conv_item(const bf16* PS, const float* cw, const float* cb, bf16* XBC, int item) {
    const int oct = item & 511, rb = item >> 9, ch = 8 * oct, t0 = 32 * rb;
    float w0[8], w1[8], w2[8], bb[8];
#pragma unroll
    for (int e = 0; e < 8; ++e) { w0[e] = cw[ch + e]; w1[e] = cw[XBCW + ch + e]; w2[e] = cw[2 * XBCW + ch + e]; bb[e] = cb[ch + e]; }
    const bf16* src = PS + 2048 + ch;
    v4u prev = (v4u){0u, 0u, 0u, 0u}, cur, nxt;
    if (t0 > 0) prev = *(const v4u*)(src + (size_t)(t0 - 1) * PSW);
    cur = *(const v4u*)(src + (size_t)t0 * PSW);
#pragma unroll 4
    for (int r = 0; r < 32; ++r) {
        const int t = t0 + r;
        nxt = (v4u){0u, 0u, 0u, 0u};
        if (t + 1 < SEQ) nxt = *(const v4u*)(src + (size_t)(t + 1) * PSW);
        float o[8];
#pragma unroll
        for (int e = 0; e < 4; ++e) {
            const unsigned pw = prev[e], cwd = cur[e], nw = nxt[e];
            const float x0 = w0[2 * e] * bflo(pw) + w1[2 * e] * bflo(cwd) + w2[2 * e] * bflo(nw) + bb[2 * e];
            const float x1 = w0[2 * e + 1] * bfhi(pw) + w1[2 * e + 1] * bfhi(cwd) + w2[2 * e + 1] * bfhi(nw) + bb[2 * e + 1];
            o[2 * e] = silu_f(x0); o[2 * e + 1] = silu_f(x1);
        }
        v4u ov; ov.x = pk2(o[0], o[1]); ov.y = pk2(o[2], o[3]); ov.z = pk2(o[4], o[5]); ov.w = pk2(o[6], o[7]);
        *(v4u*)(XBC + (size_t)t * XBCW + ch) = ov;
        prev = cur; cur = nxt;
    }
}
__device__ __forceinline__ void ssm_dt_tile(int tile, const bf16* XN, const bf16* Wdt, const float* rstd, float* DTRAW, int lane) {
    const int li = lane & 15, g = lane >> 4, t0 = 16 * tile;
    f32x4 acc0 = (f32x4){0.f, 0.f, 0.f, 0.f}, acc1 = (f32x4){0.f, 0.f, 0.f, 0.f};
    const bf16* xa = XN + (size_t)(t0 + li) * DM + 8 * g;
    const bf16* wb0 = Wdt + (size_t)li * DM + 8 * g;
    const bf16* wb1 = wb0 + (size_t)16 * DM;
#pragma unroll 8
    for (int ks = 0; ks < DM / 32; ++ks) {
        const bf16x8 a = *(const bf16x8*)(xa + 32 * ks), b0 = *(const bf16x8*)(wb0 + 32 * ks), b1 = *(const bf16x8*)(wb1 + 32 * ks);
        acc0 = mfma16(a, b0, acc0); acc1 = mfma16(a, b1, acc1);
    }
#pragma unroll
    for (int r = 0; r < 4; ++r) { const float rs = rstd[t0 + 4 * g + r];
        DTRAW[(size_t)(t0 + 4 * g + r) * 32 + li] = acc0[r] * rs; DTRAW[(size_t)(t0 + 4 * g + r) * 32 + 16 + li] = acc1[r] * rs; }
}
constexpr int XT_STRIDE = 264;
constexpr int BM_STRIDE = 136;
constexpr int SSD_XT_OFF = 0, SSD_BM_OFF = 64 * XT_STRIDE * 2  , SSD_ARR_OFF = SSD_BM_OFF + 256 * BM_STRIDE * 2  , SSD_SIN_OFF = SSD_ARR_OFF + 4096  ;
static_assert(SSD_SIN_OFF + 2 * 64 * BM_STRIDE * 2 <= MISC_OFF, "SSD LDS map");
__device__ __forceinline__ void ssd_stage_xb(int c, int h, const bf16* XBC, LAS unsigned char* lds, int tid) {
    LAS u16* XT = (LAS u16*)(lds + SSD_XT_OFF);
    LAS u16* Bm = (LAS u16*)(lds + SSD_BM_OFF);
    const int t0 = c * QCH, grp = h >> 2;
#pragma unroll
    for (int i = 0; i < 4; ++i) { const int id = tid + 512 * i, s = id >> 3, pc = id & 7;
        const v4u v = *(const v4u*)(XBC + (size_t)(t0 + s) * XBCW + h * HDIM + 8 * pc);
#pragma unroll
        for (int e = 0; e < 4; ++e) { XT[(8 * pc + 2 * e) * XT_STRIDE + s] = (u16)(v[e] & 0xffffu); XT[(8 * pc + 2 * e + 1) * XT_STRIDE + s] = (u16)(v[e] >> 16); } }
#pragma unroll
    for (int i = 0; i < 8; ++i) { const int id = tid + 512 * i, s = id >> 4, nc = id & 15;
        const v4u v = *(const v4u*)(XBC + (size_t)(t0 + s) * XBCW + SSW + grp * NST + 8 * nc);
        *(LAS v4u*)(Bm + s * BM_STRIDE + 8 * nc) = v; }
}
__device__ __forceinline__ void ssd_states_unit(int c, int h, const bf16* XBC, const float* DTRAW, const float* alog, const float* dtbias, float* DTF, float* DTB, float* ACS, float* RB, float* S,
                                                LAS unsigned char* lds, int tid) {
    const int lane = tid & 63, wave = tid >> 6, li = lane & 15, g = lane >> 4;
    LAS u16* XT = (LAS u16*)(lds + SSD_XT_OFF);
    LAS u16* Bm = (LAS u16*)(lds + SSD_BM_OFF);
    LAS float* wf = (LAS float*)(lds + SSD_ARR_OFF);
    LAS float* wb = wf + 256;
    const int t0 = c * QCH;
    __syncthreads();
    ssd_stage_xb(c, h, XBC, lds, tid);
    if (wave < 2) {
        const int dir = wave;
        const float A = -expf(alog[dir * 32 + h]), bias = dtbias[dir * 32 + h];
        float dtv[4], inc[4];
#pragma unroll
        for (int e = 0; e < 4; ++e) dtv[e] = softplus_f(DTRAW[(size_t)(t0 + 4 * lane + e) * 32 + h] + bias);
        inc[0] = dtv[0] * A; inc[1] = inc[0] + dtv[1] * A; inc[2] = inc[1] + dtv[2] * A; inc[3] = inc[2] + dtv[3] * A;
        float sc = inc[3];
#pragma unroll
        for (int o = 1; o < 64; o <<= 1) { const float t = __shfl_up(sc, o); if (lane >= o) sc += t; }
        const float excl = sc - inc[3], total = rdlane(sc, 63);
#pragma unroll
        for (int e = 0; e < 4; ++e) { const int tl = 4 * lane + e; const size_t o = (size_t)(t0 + tl) * 32 + h; const float ic = excl + inc[e];
            if (dir == 0) { wf[tl] = __expf(total - ic) * dtv[e]; DTF[o] = dtv[e]; ACS[o] = ic; }
            else { const float pre = ic - dtv[e] * A; wb[tl] = __expf(pre) * dtv[e]; DTB[o] = dtv[e]; RB[o] = total - pre; } }
    }
    __syncthreads();
    f32x4 acc[2][4];
#pragma unroll
    for (int d = 0; d < 2; ++d)
#pragma unroll
        for (int p = 0; p < 4; ++p) acc[d][p] = (f32x4){0.f, 0.f, 0.f, 0.f};
    const int n = 16 * wave + li;
#pragma unroll 2
    for (int ks = 0; ks < 8; ++ks) {
        const int s0 = 32 * ks + 8 * g;
        float bv[8];
#pragma unroll
        for (int j = 0; j < 8; ++j) bv[j] = bf2f(Bm[(s0 + j) * BM_STRIDE + n]);
        const f32x4 wf0 = *(const LAS f32x4*)(wf + s0), wf1 = *(const LAS f32x4*)(wf + s0 + 4), wb0 = *(const LAS f32x4*)(wb + s0), wb1 = *(const LAS f32x4*)(wb + s0 + 4);
        v4u fa, fbk;
        fa.x = pk2(bv[0] * wf0.x, bv[1] * wf0.y); fa.y = pk2(bv[2] * wf0.z, bv[3] * wf0.w); fa.z = pk2(bv[4] * wf1.x, bv[5] * wf1.y); fa.w = pk2(bv[6] * wf1.z, bv[7] * wf1.w);
        fbk.x = pk2(bv[0] * wb0.x, bv[1] * wb0.y); fbk.y = pk2(bv[2] * wb0.z, bv[3] * wb0.w); fbk.z = pk2(bv[4] * wb1.x, bv[5] * wb1.y); fbk.w = pk2(bv[6] * wb1.z, bv[7] * wb1.w);
        const bf16x8 af = __builtin_bit_cast(bf16x8, fa), ab = __builtin_bit_cast(bf16x8, fbk);
#pragma unroll
        for (int pt = 0; pt < 4; ++pt) {
            const bf16x8 xf = *(const LAS bf16x8*)(XT + (16 * pt + li) * XT_STRIDE + s0);
            acc[0][pt] = mfma16(af, xf, acc[0][pt]); acc[1][pt] = mfma16(ab, xf, acc[1][pt]);
        }
    }
#pragma unroll
    for (int d = 0; d < 2; ++d) { float* So = S + ((size_t)(c * 2 + d) * NHEAD + h) * (HDIM * NST);
#pragma unroll
        for (int pt = 0; pt < 4; ++pt) *(f32x4*)(So + (16 * pt + li) * NST + 16 * wave + 4 * g) = acc[d][pt]; }
}
__device__ __forceinline__ void ssd_scan_item(int e4, const float* S, const float* ACS, const float* RB, bf16* SIN) {
    const int e = 4 * e4, dir = e / (NHEAD * HDIM * NST), h = (e / (HDIM * NST)) % NHEAD;
    const size_t cs = (size_t)2 * NHEAD * HDIM * NST;
    f32x4 st = (f32x4){0.f, 0.f, 0.f, 0.f};
#pragma unroll 1
    for (int c0 = 0; c0 < NCH; c0 += 8) {
        f32x4 sv[8]; float tv[8];
#pragma unroll
        for (int i = 0; i < 8; ++i) { const int c = dir ? (NCH - 1 - (c0 + i)) : (c0 + i);
            sv[i] = *(const f32x4*)(S + c * cs + e);
            tv[i] = dir ? RB[(size_t)(c * QCH) * 32 + h] : ACS[(size_t)(c * QCH + QCH - 1) * 32 + h]; }
#pragma unroll
        for (int i = 0; i < 8; ++i) { const int c = dir ? (NCH - 1 - (c0 + i)) : (c0 + i);
            v2u o; o.x = pk2(st.x, st.y); o.y = pk2(st.z, st.w); *(v2u*)(SIN + c * cs + e) = o;
            st = st * __expf(tv[i]) + sv[i]; }
    }
}
__device__ __forceinline__ void ssd_out_unit(int c, int h, const bf16* XBC, const bf16* PS, const float* DTF, const float* DTB, const float* ACS, const float* RB, const bf16* SIN,
                                             float Dskip, bf16* YMIX, float* SSQ, LAS unsigned char* lds, int tid) {
    const int lane = tid & 63, wave = tid >> 6, li = lane & 15, g = lane >> 4;
    LAS u16* XT = (LAS u16*)(lds + SSD_XT_OFF);
    LAS u16* Bm = (LAS u16*)(lds + SSD_BM_OFF);
    LAS float* acsL = (LAS float*)(lds + SSD_ARR_OFF);
    LAS float* rbL = acsL + 256; LAS float* dtfL = acsL + 512; LAS float* dtbL = acsL + 768;
    LAS u16* SF = (LAS u16*)(lds + SSD_SIN_OFF);
    LAS u16* SB = SF + 64 * BM_STRIDE;
    const int t0 = c * QCH, grp = h >> 2;
    __syncthreads();
    ssd_stage_xb(c, h, XBC, lds, tid);
    if (tid < 256) { const size_t o = (size_t)(t0 + tid) * 32 + h; acsL[tid] = ACS[o]; rbL[tid] = RB[o]; dtfL[tid] = DTF[o]; dtbL[tid] = DTB[o]; }
    {
        const bf16* sf = SIN + ((size_t)(c * 2 + 0) * NHEAD + h) * (HDIM * NST);
        const bf16* sb = SIN + ((size_t)(c * 2 + 1) * NHEAD + h) * (HDIM * NST);
#pragma unroll
        for (int i = 0; i < 2; ++i) { const int id = tid + 512 * i, p = id >> 4, nc = id & 15;
            *(LAS v4u*)(SF + p * BM_STRIDE + 8 * nc) = *(const v4u*)(sf + p * NST + 8 * nc);
            *(LAS v4u*)(SB + p * BM_STRIDE + 8 * nc) = *(const v4u*)(sb + p * NST + 8 * nc); }
    }
    __syncthreads();
#pragma unroll 1
    for (int lt = 0; lt < 2; ++lt) {
        const int l = 32 * wave + 16 * lt + li;
        bf16x8 cf[4];
#pragma unroll
        for (int kn = 0; kn < 4; ++kn) cf[kn] = *(const bf16x8*)(XBC + (size_t)(t0 + l) * XBCW + SSW + NGRP * NST + grp * NST + 32 * kn + 8 * g);
        const float acs_l = acsL[l], rb_l = rbL[l];
        f32x4 yacc[4];
#pragma unroll
        for (int pt = 0; pt < 4; ++pt) yacc[pt] = (f32x4){0.f, 0.f, 0.f, 0.f};
#pragma unroll 2
        for (int ks = 0; ks < 8; ++ks) {
            unsigned mw[4];
#pragma unroll
            for (int st = 0; st < 2; ++st) {
                const int sb0 = 32 * ks + 16 * st;
                f32x4 d = (f32x4){0.f, 0.f, 0.f, 0.f};
#pragma unroll
                for (int kn = 0; kn < 4; ++kn) { const bf16x8 bfrag = *(const LAS bf16x8*)(Bm + (sb0 + li) * BM_STRIDE + 32 * kn + 8 * g); d = mfma16(bfrag, cf[kn], d); }
                const int s4 = sb0 + 4 * g;
                const f32x4 as4 = *(const LAS f32x4*)(acsL + s4), rs4 = *(const LAS f32x4*)(rbL + s4), df4 = *(const LAS f32x4*)(dtfL + s4), db4 = *(const LAS f32x4*)(dtbL + s4);
                float mv[4];
#pragma unroll
                for (int r = 0; r < 4; ++r) { const int s = s4 + r;
                    const float wfw = (s <= l) ? __expf(fminf(acs_l - as4[r], 0.f)) * df4[r] : 0.f;
                    const float wbw = (s >= l) ? __expf(fminf(rb_l - rs4[r], 0.f)) * db4[r] : 0.f;
                    mv[r] = d[r] * (wfw + wbw); }
                mw[2 * st] = pk2(mv[0], mv[1]); mw[2 * st + 1] = pk2(mv[2], mv[3]);
            }
            v4u mfv; mfv.x = mw[0]; mfv.y = mw[1]; mfv.z = mw[2]; mfv.w = mw[3];
            const bf16x8 mfrag = __builtin_bit_cast(bf16x8, mfv);
#pragma unroll
            for (int pt = 0; pt < 4; ++pt) {
                const LAS u16* xr = XT + (16 * pt + li) * XT_STRIDE + 32 * ks + 4 * g;
                const v2u x0 = *(const LAS v2u*)xr, x1 = *(const LAS v2u*)(xr + 16);
                v4u xv; xv.x = x0.x; xv.y = x0.y; xv.z = x1.x; xv.w = x1.y;
                yacc[pt] = mfma16(__builtin_bit_cast(bf16x8, xv), mfrag, yacc[pt]);
            }
        }
        const float ef = __expf(acs_l), eb = __expf(rb_l);
#pragma unroll
        for (int pt = 0; pt < 4; ++pt) {
            f32x4 df = (f32x4){0.f, 0.f, 0.f, 0.f}, db = (f32x4){0.f, 0.f, 0.f, 0.f};
#pragma unroll
            for (int kn = 0; kn < 4; ++kn) {
                const bf16x8 sfr = *(const LAS bf16x8*)(SF + (16 * pt + li) * BM_STRIDE + 32 * kn + 8 * g);
                const bf16x8 sbr = *(const LAS bf16x8*)(SB + (16 * pt + li) * BM_STRIDE + 32 * kn + 8 * g);
                df = mfma16(sfr, cf[kn], df); db = mfma16(sbr, cf[kn], db);
            }
            yacc[pt] = yacc[pt] + df * ef + db * eb;
        }
        const int t = t0 + l;
        float ssq = 0.f;
#pragma unroll
        for (int pt = 0; pt < 4; ++pt) {
            const int p = 16 * pt + 4 * g;
            const v2u xw = *(const v2u*)(XBC + (size_t)t * XBCW + h * HDIM + p);
            const v2u zw = *(const v2u*)(PS + (size_t)t * PSW + h * HDIM + p);
            float y0 = (yacc[pt][0] + Dskip * bflo(xw.x)) * silu_f(bflo(zw.x));
            float y1 = (yacc[pt][1] + Dskip * bfhi(xw.x)) * silu_f(bfhi(zw.x));
            float y2 = (yacc[pt][2] + Dskip * bflo(xw.y)) * silu_f(bflo(zw.y));
            float y3 = (yacc[pt][3] + Dskip * bfhi(xw.y)) * silu_f(bfhi(zw.y));
            ssq += (y0 * y0 + y1 * y1) + (y2 * y2 + y3 * y3);
            v2u o; o.x = pk2(y0, y1); o.y = pk2(y2, y3);
            *(v2u*)(YMIX + (size_t)t * DM + HYW + h * HDIM + p) = o;
        }
        ssq += __shfl_xor(ssq, 16); ssq += __shfl_xor(ssq, 32);
        if (g == 0) SSQ[(size_t)t * 32 + h] = ssq;
    }
}
__device__ __forceinline__ void mixer_norm_unit(int tb, const bf16* Z2T, const float* hog, const float* SSQ, const float* sog, bf16* YMIX, LAS unsigned char* lds, int tid) {
    LAS float* red = (LAS float*)lds;
    LAS float* rsh = (LAS float*)(lds + 16640);
    LAS float* rss = rsh + 64;
    LAS u16* tile = (LAS u16*)(lds + 20480);
    constexpr int TS = 264;
    const int t0 = 64 * tb, j = tid & 7, cc = tid >> 3;
    __syncthreads();
    float ps[8];
#pragma unroll
    for (int e = 0; e < 8; ++e) ps[e] = 0.f;
#pragma unroll 16
    for (int cbk = 0; cbk < 32; ++cbk) {
        const v4u v = *(const v4u*)(Z2T + (size_t)(64 * cbk + cc) * SEQ + t0 + 8 * j);
#pragma unroll
        for (int e = 0; e < 4; ++e) { const float a = bflo(v[e]), b = bfhi(v[e]); ps[2 * e] += a * a; ps[2 * e + 1] += b * b; }
    }
#pragma unroll
    for (int e = 0; e < 8; ++e) red[cc * 65 + 8 * j + e] = ps[e];
    __syncthreads();
    if (tid < 64) { float s = 0.f; for (int k = 0; k < 64; ++k) s += red[k * 65 + tid]; rsh[tid] = 1.0f / sqrtf(s * (1.f / HYW) + EPS); }
    { const int tk = tid >> 3, gq = tid & 7; const f32x4 q = *(const f32x4*)(SSQ + (size_t)(t0 + tk) * 32 + 4 * gq); rss[tk * 8 + gq] = 1.0f / sqrtf(((q.x + q.y) + (q.z + q.w)) * (1.f / 256.f) + EPS); }
    v4u cur[4], nxt[4];
#pragma unroll
    for (int i = 0; i < 4; ++i) cur[i] = *(const v4u*)(Z2T + (size_t)(cc + 64 * i) * SEQ + t0 + 8 * j);
#pragma unroll 1
    for (int cb4 = 0; cb4 < 8; ++cb4) {
        if (cb4 + 1 < 8) {
#pragma unroll
            for (int i = 0; i < 4; ++i) nxt[i] = *(const v4u*)(Z2T + (size_t)(256 * (cb4 + 1) + cc + 64 * i) * SEQ + t0 + 8 * j); }
#pragma unroll
        for (int i = 0; i < 4; ++i)
#pragma unroll
            for (int e = 0; e < 4; ++e) { tile[(8 * j + 2 * e) * TS + cc + 64 * i] = (u16)(cur[i][e] & 0xffffu); tile[(8 * j + 2 * e + 1) * TS + cc + 64 * i] = (u16)(cur[i][e] >> 16); }
        __syncthreads();
        { const int tk = tid >> 3; const float r = rsh[tk];
#pragma unroll
          for (int i = 0; i < 4; ++i) { const int c8 = (tid & 7) + 8 * i; const v4u w = *(const LAS v4u*)(tile + tk * TS + 8 * c8);
            const f32x4 g0 = *(const f32x4*)(hog + 256 * cb4 + 8 * c8), g1 = *(const f32x4*)(hog + 256 * cb4 + 8 * c8 + 4);
            v4u o; o.x = pk2(bflo(w.x) * r * g0.x, bfhi(w.x) * r * g0.y); o.y = pk2(bflo(w.y) * r * g0.z, bfhi(w.y) * r * g0.w);
            o.z = pk2(bflo(w.z) * r * g1.x, bfhi(w.z) * r * g1.y); o.w = pk2(bflo(w.w) * r * g1.z, bfhi(w.w) * r * g1.w);
            *(v4u*)(YMIX + (size_t)(t0 + tk) * DM + 256 * cb4 + 8 * c8) = o; } }
        __syncthreads();
#pragma unroll
        for (int i = 0; i < 4; ++i) cur[i] = nxt[i];
    }
#pragma unroll 8
    for (int i = 0; i < 32; ++i) { const int id = tid + 512 * i, tk = id >> 8, oc = id & 255;
        bf16* ptr = YMIX + (size_t)(t0 + tk) * DM + HYW + 8 * oc; const v4u w = *(const v4u*)ptr; const float r = rss[tk * 8 + (oc >> 5)];
        const f32x4 g0 = *(const f32x4*)(sog + 8 * oc), g1 = *(const f32x4*)(sog + 8 * oc + 4);
        v4u o; o.x = pk2(bflo(w.x) * r * g0.x, bfhi(w.x) * r * g0.y); o.y = pk2(bflo(w.y) * r * g0.z, bfhi(w.y) * r * g0.w);
        o.z = pk2(bflo(w.z) * r * g1.x, bfhi(w.z) * r * g1.y); o.w = pk2(bflo(w.w) * r * g1.z, bfhi(w.w) * r * g1.w);
        *(v4u*)ptr = o; }
}

#ifndef MK_ONE_LAUNCH
#define MK_ONE_LAUNCH 1
#endif
constexpr int NPH = 12, PH_FINAL = 1 + DEPTH * NPH, PH_TOTAL = PH_FINAL + 1;
struct Args { const float* in[N_INPUTS]; float* out; unsigned char* ws; int ph_lo, ph_hi, use_bar, pad; };

__global__ void __launch_bounds__(512, 2) mk_fwd(Args a) {
    extern __shared__ __attribute__((aligned(16))) unsigned char lds_raw[];
    LAS unsigned char* lds = (LAS unsigned char*)lds_raw;
    const int G = gridDim.x, bid = blockIdx.x;
    const int wave_s = __builtin_amdgcn_readfirstlane((int)threadIdx.x >> 6);
    volatile LAS unsigned* MISC = (volatile LAS unsigned*)(lds + MISC_OFF);
    if (threadIdx.x < 64) MISC[threadIdx.x] = 0u;
    __syncthreads();
    unsigned* ctl = (unsigned*)(a.ws + WS_CTL);
    XcdBarrier bar; bar.bar = ctl + CW_BAR; bar.x = 0; bar.st = MISC + 8;
    if (a.use_bar) bar = xcd_barrier_post(ctl + CW_BAR, MISC + 8);
    const int lo = a.ph_lo, hi = a.ph_hi;
#ifndef MK_C1
#define MK_C1 1
#endif
#ifndef MK_C2
#define MK_C2 1
#endif
#ifndef MK_REP_MASK
#define MK_REP_MASK 0u
#endif
#define REPS(k) ((((unsigned)MK_REP_MASK >> (k)) & 1u) ? 2 : 1)
#define REP_LOOP(k) for (int rep_ = 0; rep_ < REPS(k); ++rep_)
#define REP_SEAM(k) do { if (rep_ + 1 < REPS(k)) xcd_barrier(bar); } while (0)
#ifndef MK_TAPS
#define MK_TAPS 1
#endif
#ifndef MK_PHMASK
#define MK_PHMASK 0xFFFFu
#endif
#define IN(p) (lo <= (p) && (p) < hi)
#define INL(k) (((MK_PHMASK >> (k)) & 1u) && IN(pb + (k)))
#ifndef MK_DBL_BAR
#define MK_DBL_BAR 0
#endif
#define SEAM(p) do { if (IN(p) && IN((p) + 1)) { xcd_barrier(bar); if (MK_DBL_BAR) xcd_barrier(bar); } } while (0)
#define CAS __attribute__((address_space(4)))
#define PHASE_BEGIN \
    const char CAS* kp = (const char CAS*)__builtin_amdgcn_kernarg_segment_ptr(); asm volatile("" : "+s"(kp)); \
    unsigned char* ws = *(unsigned char* const CAS*)(kp + 8 * (N_INPUTS + 1)); \
    unsigned z_ = 0u; asm volatile("" : "+v"(z_)); int wv_ = wave_s; asm volatile("" : "+s"(wv_)); \
    const int tid = wv_ * 64 + (int)__builtin_amdgcn_mbcnt_hi(~0u, __builtin_amdgcn_mbcnt_lo(~0u, z_)); \
    const int lane = tid & 63, wave = wave_s; \
    const int vcu = (G % 8 == 0) ? (bid % 8) * (G / 8) + bid / 8 : bid; \
    const int gw = vcu * 8 + wave, NGW = G * 8; (void)lane; (void)gw; (void)NGW; (void)ws
#define INP(i) (*(const float* const CAS*)(kp + 8 * (i)))
#define OUTP() (*(float* const CAS*)(kp + 8 * N_INPUTS))
#define WSP(T, off) ((T*)(ws + (off)))

    if (IN(0)) {
        PHASE_BEGIN;
        f32x2* TW = WSP(f32x2, WS_TW); f32x2* PW = WSP(f32x2, WS_PW);
        for (int i = bid * 512 + tid; i < 16384 + 8193; i += G * 512) {
            float s, c;
            if (i < 16384) { sincospif((float)i / 8192.0f, &s, &c); TW[i] = (f32x2){c, -s}; }
            else { const int k = i - 16384; sincospif((float)k / 16384.0f, &s, &c); PW[k] = (f32x2){c, -s}; }
        }
    }

#pragma unroll 1
    for (int l = 0; l < DEPTH; ++l) {
        const int pb = 1 + l * NPH;
        if (INL(0)) REP_LOOP(0) {
            PHASE_BEGIN;
            LAS float* scr = (LAS float*)(lds + wave * 16384);
            const float* win = INP(I_WIN) + (size_t)l * DM * NIN; const float* wo = INP(I_WO) + (size_t)l * DM * DM;
            const float* wup = INP(I_WUP) + (size_t)l * DM * DFF; const float* wdn = INP(I_WDN) + (size_t)l * DFF * DM;
            bf16* WIN = WSP(bf16, WS_WIN); bf16* WOUT = WSP(bf16, WS_WOUT); bf16* WUP = WSP(bf16, WS_WUP); bf16* WDN = WSP(bf16, WS_WDN);
            const float* gmix = INP(I_NMG) + (size_t)l * DM; const float* gmlp = INP(I_NLG) + (size_t)l * DM;
            constexpr int IT_IN = (DM / 64) * (NIN / 32), IT_O = (DM / 64) * (DM / 32), IT_UP = (DM / 64) * (DFF / 32), IT_DN = (DFF / 64) * (DM / 32);
            for (int it = gw; it < IT_IN + IT_O + IT_UP + IT_DN; it += NGW) {
                int r = it;
                if (r < IT_IN) { transpose_item(win, DM, NIN, WIN, scr, r, lane, gmix); continue; } r -= IT_IN;
                if (r < IT_O) { transpose_item(wo, DM, DM, WOUT, scr, r, lane, nullptr); continue; } r -= IT_O;
                if (r < IT_UP) { transpose_item(wup, DM, DFF, WUP, scr, r, lane, gmlp); continue; } r -= IT_UP;
                transpose_item(wdn, DFF, DM, WDN, scr, r, lane, nullptr);
            }
            if (l == 0) { const float* xin = INP(I_X); bf16* XB = WSP(bf16, WS_XN); float* sa = WSP(float, WS_SSQA);
                for (int m = gw; m < SEQ; m += NGW) prep_row(xin + (size_t)m * DM, XB + (size_t)m * DM, sa + m, lane); }
            else { const int i = bid * 512 + tid; if (i < SEQ) rstd_reduce(WSP(const float, WS_PARTA), WSP(float, WS_SSQA), i);
                   if (bid == 0) for (int i2 = G * 512 + tid; i2 < SEQ; i2 += 512) rstd_reduce(WSP(const float, WS_PARTA), WSP(float, WS_SSQA), i2); }
            const float* w1 = INP(I_PW1) + (size_t)l * 33 * 64; const float* b1 = INP(I_PB1) + (size_t)l * 64;
            const float* w2 = INP(I_PW2) + (size_t)l * 64 * 64; const float* b2 = INP(I_PB2) + (size_t)l * 64;
            const float* w3 = INP(I_PW3) + (size_t)l * 64 * 64; const float* b3 = INP(I_PB3) + (size_t)l * 64;
            const float* sf = INP(I_SF) + (size_t)l * 3 * 64; bf16* H3 = WSP(bf16, WS_H3);
            for (int t = gw; t < SEQ; t += NGW) posmlp_row(t, w1, b1, w2, b2, w3, b3, sf, H3 + (size_t)t * 64, lane);
            REP_SEAM(0);
        }
        SEAM(pb + 0);
        if (INL(1)) REP_LOOP(1) {
            PHASE_BEGIN;
            pg8::Gemm g{WSP(bf16, WS_WIN), WSP(bf16, WS_XN), 3 * HYW, SEQ, DM}; pg8::StaticOrder S; S.init(3 * HYW, SEQ, G, bid);
            pg8::EpiBf16P<0, 2> E{WSP(bf16, WS_PT), SEQ, WSP(const float, WS_SSQA)};
            pg8::gemm_phase<pg8::EpiBf16P<0, 2>, pg8::StaticOrder, true, true>(lds, g, S, E, tid);
            REP_SEAM(1);
        }
        if (INL(2)) {
            PHASE_BEGIN;
            pg8::Gemm g{WSP(bf16, WS_XN), WSP(bf16, WS_WIN) + (size_t)3 * HYW * DM, SEQ, PSW, DM}; pg8::StaticOrder S; S.init(SEQ, PSW, G, bid);
            pg8::EpiBf16P<0, 1> E{WSP(bf16, WS_PS), PSW, WSP(const float, WS_SSQA)};
            pg8::gemm_phase<pg8::EpiBf16P<0, 1>, pg8::StaticOrder, true, true>(lds, g, S, E, tid);
        }
        if (INL(2)) REP_LOOP(12) {
            PHASE_BEGIN;
            if (rep_) xcd_barrier(bar);
            if (MK_TAPS) taps_gemm(INP(I_WOUTF) + (size_t)l * 64 * NTAP, WSP(bf16, WS_H3), WSP(bf16, WS_HT), gw, NGW, lane);
        }
        SEAM(pb + 2);
        if (MK_C1 && INL(3)) REP_LOOP(13) {
            PHASE_BEGIN;
            if (rep_) xcd_barrier(bar);
            for (int tile = gw; tile < SEQ / 16; tile += NGW) ssm_dt_tile(tile, WSP(bf16, WS_XN), WSP(bf16, WS_WIN) + (size_t)(3 * HYW + PSW) * DM, WSP(const float, WS_SSQA), WSP(float, WS_DTRAW), lane);
            { const float* cw = INP(I_SCW) + (size_t)l * 3 * XBCW; const float* cb = INP(I_SCB) + (size_t)l * XBCW;
              for (int it = bid * 512 + tid; it < 512 * 512; it += G * 512) ssm_conv_item(WSP(bf16, WS_PS), cw, cb, WSP(bf16, WS_XBC), it); }
        }
        if (MK_C2 && INL(3)) REP_LOOP(3) {
            PHASE_BEGIN;
            if (rep_) xcd_barrier(bar);
            const float* cw = INP(I_HCW) + (size_t)l * 3 * 3 * HYW; const float* cb = INP(I_HCB) + (size_t)l * 3 * HYW; const float* sk = INP(I_SKIP) + (size_t)l * 2 * HYW;
            __syncthreads(); fft_fill_twl(WSP(f32x2, WS_TW), WSP(f32x2, WS_PW), lds, tid); __syncthreads();
            for (int c = bid; c < HYW; c += G) hyena_channel(c, WSP(bf16, WS_PT), WSP(bf16, WS_HT), cw, cb, sk, WSP(bf16, WS_Z2T), (f32x4*)(ws + WS_GSCR + (size_t)bid * GSCR_PER_WG), lds, tid);
        }
        SEAM(pb + 3);
        if (INL(4)) REP_LOOP(4) { PHASE_BEGIN; if (rep_) xcd_barrier(bar);
            for (int u = vcu; u < NCH * NHEAD; u += G) ssd_states_unit(u >> 5, u & 31, WSP(bf16, WS_XBC), WSP(float, WS_DTRAW), INP(I_ALOG) + (size_t)l * 64, INP(I_DTB) + (size_t)l * 64,
                                                                       WSP(float, WS_DTF), WSP(float, WS_DTB), WSP(float, WS_ACS), WSP(float, WS_RB), WSP(float, WS_S), lds, tid); }
        SEAM(pb + 4);
        if (INL(5)) REP_LOOP(5) { PHASE_BEGIN; if (rep_) xcd_barrier(bar);
            for (int e4 = bid * 512 + tid; e4 < 2 * NHEAD * HDIM * NST / 4; e4 += G * 512) ssd_scan_item(e4, WSP(float, WS_S), WSP(float, WS_ACS), WSP(float, WS_RB), WSP(bf16, WS_SIN)); }
        SEAM(pb + 5);
        if (INL(6)) REP_LOOP(6) { PHASE_BEGIN; if (rep_) xcd_barrier(bar); const float* sd = INP(I_SD) + (size_t)l * NHEAD;
            for (int u = vcu; u < NCH * NHEAD; u += G) ssd_out_unit(u >> 5, u & 31, WSP(bf16, WS_XBC), WSP(bf16, WS_PS), WSP(float, WS_DTF), WSP(float, WS_DTB), WSP(float, WS_ACS), WSP(float, WS_RB),
                                                                    WSP(bf16, WS_SIN), sd[u & 31], WSP(bf16, WS_YMIX), WSP(float, WS_SSQ), lds, tid); }
        SEAM(pb + 6);
        if (INL(7)) { PHASE_BEGIN;
            for (int tb = bid; tb < SEQ / 64; tb += G) mixer_norm_unit(tb, WSP(bf16, WS_Z2T), INP(I_HOG) + (size_t)l * HYW, WSP(float, WS_SSQ), INP(I_SOG) + (size_t)l * SSW, WSP(bf16, WS_YMIX), lds, tid); }
        SEAM(pb + 7);
        if (INL(8)) { PHASE_BEGIN;
            pg8::Gemm g{WSP(bf16, WS_YMIX), WSP(bf16, WS_WOUT), SEQ, DM, DM}; pg8::StaticOrder S; S.init(SEQ, DM, G, bid);
            pg8::EpiRes E{(l == 0) ? INP(I_X) : WSP(const float, WS_X), WSP(float, WS_X), WSP(bf16, WS_XN), WSP(float, WS_PARTB), DM, SEQ};
            pg8::gemm_phase<pg8::EpiRes, pg8::StaticOrder, true, true>(lds, g, S, E, tid); }
        SEAM(pb + 8);
        if (INL(9)) { PHASE_BEGIN; const int i = bid * 512 + tid; if (i < SEQ) rstd_reduce(WSP(const float, WS_PARTB), WSP(float, WS_SSQB), i);
            if (bid == 0) for (int i2 = G * 512 + tid; i2 < SEQ; i2 += 512) rstd_reduce(WSP(const float, WS_PARTB), WSP(float, WS_SSQB), i2); }
        SEAM(pb + 9);
        if (INL(10)) REP_LOOP(10) { PHASE_BEGIN; if (rep_) xcd_barrier(bar);
            pg8::Gemm g{WSP(bf16, WS_XN), WSP(bf16, WS_WUP), SEQ, DFF, DM}; pg8::StaticOrder S; S.init(SEQ, DFF, G, bid);
            pg8::EpiBf16P<1, 1> E{WSP(bf16, WS_H), DFF, WSP(const float, WS_SSQB)};
            pg8::gemm_phase<pg8::EpiBf16P<1, 1>, pg8::StaticOrder, true, true>(lds, g, S, E, tid); }
        SEAM(pb + 10);
        if (INL(11)) { PHASE_BEGIN;
            pg8::Gemm g{WSP(bf16, WS_H), WSP(bf16, WS_WDN), SEQ, DM, DFF}; pg8::StaticOrder S; S.init(SEQ, DM, G, bid);
            pg8::EpiRes E{WSP(const float, WS_X), WSP(float, WS_X), WSP(bf16, WS_XN), WSP(float, WS_PARTA), DM, SEQ};
            pg8::gemm_phase<pg8::EpiRes, pg8::StaticOrder, true, true>(lds, g, S, E, tid); }
        SEAM(pb + 11);
    }
    if (IN(PH_FINAL)) { PHASE_BEGIN; const float* X = WSP(const float, WS_X); float* out = OUTP();
        for (int m = gw; m < SEQ; m += NGW) rms_row<false>(X + (size_t)m * DM, INP(I_FNG), out + (size_t)m * DM, lane); }
#undef IN
#undef INL
#undef SEAM
}

extern "C" void kernel_launch(void* const* d_in, const int* in_sizes, int n_in, void* d_out, int out_size, void* d_ws, size_t ws_size, hipStream_t stream) {
    static int grid = 0;
    if (grid == 0) {
        if (n_in != N_INPUTS || in_sizes[0] != SEQ * DM || out_size != SEQ * DM || ws_size < WS_END) {
            fprintf(stderr, "kernel_launch: unexpected problem: n_in %d in0 %d out %d ws %zu (need %zu)\n", n_in, n_in > 0 ? in_sizes[0] : -1, out_size, ws_size, (size_t)WS_END); grid = -1; return; }
        int dev = 0, cus = 0;
        if (hipGetDevice(&dev) != hipSuccess || hipDeviceGetAttribute(&cus, hipDeviceAttributeMultiprocessorCount, dev) != hipSuccess) { grid = -1; return; }
        if (hipFuncSetAttribute((const void*)mk_fwd, hipFuncAttributeMaxDynamicSharedMemorySize, LDS_BYTES) != hipSuccess) { fprintf(stderr, "kernel_launch: hipFuncSetAttribute failed\n"); grid = -1; return; }
        int per_cu = 0;
        if (hipOccupancyMaxActiveBlocksPerMultiprocessor(&per_cu, (const void*)mk_fwd, 512, LDS_BYTES) != hipSuccess || per_cu < 1) fprintf(stderr, "kernel_launch: occupancy query reports %d\n", per_cu);
        (void)hipGetLastError();
        grid = cus;
    }
    if (grid < 0) return;
    if (hipMemsetAsync((char*)d_ws + WS_CTL, 0, CTL_ZERO_BYTES, stream) != hipSuccess) return;
    Args a{};
    for (int i = 0; i < N_INPUTS; ++i) a.in[i] = (const float*)d_in[i];
    a.out = (float*)d_out; a.ws = (unsigned char*)d_ws; a.pad = 0;
#if MK_ONE_LAUNCH
    a.ph_lo = 0; a.ph_hi = PH_TOTAL; a.use_bar = 1;
    hipLaunchKernelGGL(mk_fwd, dim3(grid), dim3(512), LDS_BYTES, stream, a);
#else
    for (int p = 0; p < PH_TOTAL; ++p) { a.ph_lo = p; a.ph_hi = p + 1; a.use_bar = 0;
        hipLaunchKernelGGL(mk_fwd, dim3(grid), dim3(512), LDS_BYTES, stream, a); }
#endif
}
```

```cpp
#include <hip/hip_runtime.h>
#include <cstdio>
#include <cstdint>
namespace pg8 {
#define PG8_LAS __attribute__((address_space(3)))
typedef unsigned short bf16_t;
typedef short bf16x8 __attribute__((ext_vector_type(8)));
typedef float f32x4 __attribute__((ext_vector_type(4)));
typedef unsigned u32x4 __attribute__((ext_vector_type(4)));
constexpr int BM = 256, BK = 64, HALF = 128, HTB = HALF * BK * 2  , STAGE_BYTES = 8 * HTB, NXCD = 8, WGM = 8;

__host__ __device__ __forceinline__ int lds_byte(int r, int c) { const int st = (r >> 4) * 2 + (c >> 5), rr = r & 15, cc = c & 31, ob = rr * 64 + cc * 2; return st * 1024 + (ob ^ (((ob >> 9) & 1) << 5)); }
__host__ __device__ __forceinline__ void stage_rc(int b, int& R, int& C) { const int st = b / 1024, sb = b % 1024, swz = sb ^ (((sb >> 9) & 1) << 5); R = (st >> 1) * 16 + swz / 64; C = (st & 1) * 32 + (swz % 64) / 2; }
__host__ __device__ __forceinline__ int perm32(int rho) { const int n = rho >> 4, i = rho & 15; return 8 * (i >> 2) + 4 * n + (i & 3); }

struct Unit { int pm, pn; };
struct Gemm { const bf16_t* A; const bf16_t* Bt; int M, N, K; };

struct StaticOrder {
    int nM, nN, nwg, G, c;
    __host__ __device__ void init(int M, int N, int G_, int c_) { nM = M / BM; nN = N / BM; nwg = nM * nN; G = G_; c = c_; }
    __host__ __device__ bool next(int i, Unit& u) const {
        const long L = (long)i * G + c; if (L >= nwg) return false;
        int wgid = (int)L; { const int q = nwg / NXCD, r = nwg % NXCD, xcd = wgid % NXCD, off = wgid / NXCD; wgid = (xcd < r ? xcd * (q + 1) : r * (q + 1) + (xcd - r) * q) + off; }
        const int nig = WGM * nN, gid = wgid / nig, fm = gid * WGM, gsz = (nM - fm) < WGM ? (nM - fm) : WGM;
        u.pm = fm + ((wgid % nig) % gsz); u.pn = (wgid % nig) / gsz; return true;
    }
    __device__ __forceinline__ void a_ready(const Unit&) const {}
    __device__ __forceinline__ void done(const Unit&) const {}
};

__device__ __forceinline__ unsigned cvt_pk_bf16(float lo, float hi) { unsigned r; asm volatile("v_cvt_pk_bf16_f32 %0, %1, %2" : "=v"(r) : "v"(lo), "v"(hi)); return r; }
__device__ __forceinline__ float rstd_of(float ssq) { return 1.0f / sqrtf(ssq * (1.0f / 4096.0f) + 1e-5f); }
template <int ACT, int MODE> struct EpiBf16P {
    static constexpr bool PERM = true, AFTER_DRAIN = false;
    bf16_t* O; int ldc; const float* rstd;
    __device__ __forceinline__ void operator()(const f32x4 (&acc)[2][2][4][2], const Unit& u, int wr, int wc, int fr, int fq) const {
        const int row0 = u.pm * BM + wr * 64 + fr, col0 = u.pn * BM + wc * 32 + 8 * fq;
        f32x4 cs[2][2];
        if (MODE == 2) {
#pragma unroll
            for (int bj = 0; bj < 2; ++bj)
#pragma unroll
                for (int n = 0; n < 2; ++n) cs[bj][n] = *(const f32x4*)(rstd + col0 + bj * HALF + 4 * n);
        }
#pragma unroll
        for (int ai = 0; ai < 2; ++ai)
#pragma unroll
            for (int m = 0; m < 4; ++m) { const int row = row0 + ai * HALF + m * 16; bf16_t* rowp = O + (size_t)row * ldc + col0;
                float rs = 1.f; if (MODE == 1) rs = rstd[row];
#pragma unroll
                for (int bj = 0; bj < 2; ++bj) { f32x4 v0 = acc[ai][bj][m][0], v1 = acc[ai][bj][m][1];
                    if (MODE == 1) { v0 = v0 * rs; v1 = v1 * rs; }
                    if (MODE == 2) { v0 = v0 * cs[bj][0]; v1 = v1 * cs[bj][1]; }
                    if (ACT == 1) {
#pragma unroll
                        for (int j = 0; j < 4; ++j) { const float a = fmaxf(v0[j], 0.f), b = fmaxf(v1[j], 0.f); v0[j] = a * a; v1[j] = b * b; } }
                    u32x4 w; w.x = cvt_pk_bf16(v0[0], v0[1]); w.y = cvt_pk_bf16(v0[2], v0[3]); w.z = cvt_pk_bf16(v1[0], v1[1]); w.w = cvt_pk_bf16(v1[2], v1[3]);
                    *(u32x4*)(rowp + bj * HALF) = w; } }
    }
};
struct EpiRes {
    static constexpr bool PERM = true, AFTER_DRAIN = false;
    bf16_t* xb; float* out32; float* part; int ldc, nrows, last;
    __device__ __forceinline__ void operator()(const f32x4 (&acc)[2][2][4][2], const Unit& u, int wr, int wc, int fr, int fq) const {
        const int row0 = u.pm * BM + wr * 64 + fr, col0 = u.pn * BM + wc * 32 + 8 * fq;
#pragma unroll
        for (int ai = 0; ai < 2; ++ai) {
            u32x4 bs[4][2];
#pragma unroll
            for (int m = 0; m < 4; ++m) { const size_t off = (size_t)(row0 + ai * HALF + m * 16) * ldc + col0;
#pragma unroll
                for (int bj = 0; bj < 2; ++bj) bs[m][bj] = *(const u32x4*)(xb + off + bj * HALF); }
            asm volatile("" ::: "memory");
#pragma unroll
            for (int m = 0; m < 4; ++m) { const int row = row0 + ai * HALF + m * 16; const size_t off = (size_t)row * ldc + col0;
                float sq = 0.f;
#pragma unroll
                for (int bj = 0; bj < 2; ++bj) { const u32x4 b = bs[m][bj];
                    f32x4 r0, r1;
                    r0[0] = __uint_as_float(b.x << 16); r0[1] = __uint_as_float(b.x & 0xffff0000u); r0[2] = __uint_as_float(b.y << 16); r0[3] = __uint_as_float(b.y & 0xffff0000u);
                    r1[0] = __uint_as_float(b.z << 16); r1[1] = __uint_as_float(b.z & 0xffff0000u); r1[2] = __uint_as_float(b.w << 16); r1[3] = __uint_as_float(b.w & 0xffff0000u);
                    const f32x4 o0 = r0 + acc[ai][bj][m][0], o1 = r1 + acc[ai][bj][m][1];
                    if (last) { *(f32x4*)(out32 + off + bj * HALF) = o0; *(f32x4*)(out32 + off + bj * HALF + 4) = o1; }
                    else { u32x4 w; w.x = cvt_pk_bf16(o0[0], o0[1]); w.y = cvt_pk_bf16(o0[2], o0[3]); w.z = cvt_pk_bf16(o1[0], o1[1]); w.w = cvt_pk_bf16(o1[2], o1[3]);
                           *(u32x4*)(xb + off + bj * HALF) = w; }
                    sq += ((o0[0] * o0[0] + o0[1] * o0[1]) + (o0[2] * o0[2] + o0[3] * o0[3])) + ((o1[0] * o1[0] + o1[1] * o1[1]) + (o1[2] * o1[2] + o1[3] * o1[3])); }
                sq += __shfl_xor(sq, 16); sq += __shfl_xor(sq, 32);
                if (fq == 0) part[(size_t)(4 * u.pn + wc) * nrows + row] = sq; }
            asm volatile("" ::: "memory");
        }
    }
};

template <class Epi, class Sched, bool ALIGN_EPI = false, bool SP2 = false>
__device__ __forceinline__ void gemm_phase(PG8_LAS unsigned char* lds, const Gemm g, const Sched& S, const Epi& E, int tid_arg) {
    int tid_ = tid_arg; asm volatile("" : "+v"(tid_));
    const int tid = tid_, wid = __builtin_amdgcn_readfirstlane(tid >> 6), lane = tid & 63, wr = wid >> 2, wc = wid & 3, fr = lane & 15, fq = lane >> 4;
    const int K = g.K, nt = K / BK;
    unsigned voffA[2], voffB[2];
#pragma unroll
    for (int i = 0; i < 2; ++i) { int R, C; stage_rc(tid * 16 + i * 8192, R, C); const int Rb = Epi::PERM ? ((R & ~31) + perm32(R & 31)) : R;
        voffA[i] = (unsigned)(R * K + C) * 2u; voffB[i] = (unsigned)(Rb * K + C) * 2u; }
    const size_t kstep = (size_t)(BK * 2);
    const size_t hstep = (size_t)HALF * K * 2;
    const size_t tstep = 2 * hstep;
    const unsigned ldsw = (unsigned)wid * 1024u;
    const int aoff = lds_byte(wr * 64 + fr, fq * 8), boff = lds_byte(wc * 32 + fr, fq * 8);
#define PG8_SA(b, h) (((b) * 2 + (h)) * HTB)
#define PG8_SB(b, h) ((4 + (b) * 2 + (h)) * HTB)
#define PG8_STAGE(bufoff, gbase, voff) do { _Pragma("unroll") for (int _i = 0; _i < 2; ++_i) \
        __builtin_amdgcn_global_load_lds((const unsigned*)((const char*)(gbase) + (voff)[_i]), (PG8_LAS unsigned*)(lds + (bufoff) + ldsw + _i * 8192), 16, 0, 0); } while (0)
#define PG8_LDA(dst, b, h) do { _Pragma("unroll") for (int m = 0; m < 4; ++m) _Pragma("unroll") for (int k = 0; k < 2; ++k) dst[m][k] = *(const PG8_LAS bf16x8*)(lds + PG8_SA(b, h) + aoff + m * 2048 + k * 1024); } while (0)
#define PG8_LDB(dst, b, h) do { _Pragma("unroll") for (int n = 0; n < 2; ++n) _Pragma("unroll") for (int k = 0; k < 2; ++k) dst[n][k] = *(const PG8_LAS bf16x8*)(lds + PG8_SB(b, h) + boff + n * 2048 + k * 1024); } while (0)
#define PG8_MMA(ai, bj, At, Bt) do { __builtin_amdgcn_s_setprio(1); _Pragma("unroll") for (int m = 0; m < 4; ++m) _Pragma("unroll") for (int n = 0; n < 2; ++n) _Pragma("unroll") for (int k = 0; k < 2; ++k) \
        acc[ai][bj][m][n] = __builtin_amdgcn_mfma_f32_16x16x32_bf16(Bt[n][k], At[m][k], acc[ai][bj][m][n], 0, 0, 0); __builtin_amdgcn_s_setprio(0); } while (0)
#define PG8_WAIT_V(n) asm volatile("s_waitcnt vmcnt(" #n ")" ::: "memory")
#define PG8_WAIT_L(n) asm volatile("s_waitcnt lgkmcnt(" #n ")" ::: "memory")
#define PG8_BAR __builtin_amdgcn_s_barrier()
#define PG8_SCHED __builtin_amdgcn_sched_barrier(0)
    Unit cur, nxt; int ui = 0;
    if (!S.next(0, cur)) return;
    f32x4 acc[2][2][4][2];
#pragma unroll
    for (int a = 0; a < 2; ++a)
#pragma unroll
        for (int b = 0; b < 2; ++b)
#pragma unroll
            for (int m = 0; m < 4; ++m)
#pragma unroll
                for (int n = 0; n < 2; ++n) acc[a][b][m][n] = (f32x4){0.f, 0.f, 0.f, 0.f};
    bf16x8 At[4][2], B0[2][2], B1[2][2];
    const char* cA = (const char*)g.A + (size_t)cur.pm * tstep; const char* cB = (const char*)g.Bt + (size_t)cur.pn * tstep;
    S.a_ready(cur);
    if constexpr (SP2) {
        PG8_STAGE(PG8_SB(0, 0), cB, voffB); PG8_STAGE(PG8_SB(0, 1), cB + hstep, voffB); PG8_STAGE(PG8_SA(0, 0), cA, voffA); PG8_STAGE(PG8_SA(0, 1), cA + hstep, voffA);
        if (wr == 1) PG8_BAR;
        PG8_WAIT_V(2); PG8_BAR;
        PG8_STAGE(PG8_SB(1, 0), cB + kstep, voffB); PG8_STAGE(PG8_SA(1, 0), cA + kstep, voffA); PG8_STAGE(PG8_SB(1, 1), cB + hstep + kstep, voffB);
        PG8_WAIT_V(6); PG8_BAR;
    } else {
        PG8_STAGE(PG8_SB(0, 0), cB, voffB); PG8_STAGE(PG8_SA(0, 0), cA, voffA); PG8_STAGE(PG8_SB(0, 1), cB + hstep, voffB); PG8_STAGE(PG8_SA(0, 1), cA + hstep, voffA);
        if (wr == 1) PG8_BAR;
        PG8_WAIT_V(4); PG8_BAR;
        PG8_STAGE(PG8_SB(1, 0), cB + kstep, voffB); PG8_STAGE(PG8_SA(1, 0), cA + kstep, voffA); PG8_STAGE(PG8_SB(1, 1), cB + hstep + kstep, voffB);
        PG8_WAIT_V(6); PG8_BAR;
    }
    for (;;) {
        const bool has_next = S.next(ui + 1, nxt);
        const char* nA = has_next ? (const char*)g.A + (size_t)nxt.pm * tstep : cA; const char* nB = has_next ? (const char*)g.Bt + (size_t)nxt.pn * tstep : cB;
        asm volatile(".p2align 6" ::: "memory");
        for (int t = 0; t < nt; t += 2) {
            const bool last = (t == nt - 2);
            const char* a1 = cA + (size_t)(t + 1) * kstep;
            const char* a2 = last ? nA : cA + (size_t)(t + 2) * kstep; const char* b2 = last ? nB : cB + (size_t)(t + 2) * kstep;
            const char* a3 = a2 + kstep; const char* b3 = b2 + kstep;
            if (last && has_next) S.a_ready(nxt);
            if constexpr (SP2) {
            PG8_LDB(B0, 0, 0); PG8_LDB(B1, 0, 1); PG8_SCHED; PG8_LDA(At, 0, 0); PG8_STAGE(PG8_SA(1, 1), a1 + hstep, voffA);
            PG8_WAIT_V(8); PG8_WAIT_L(0); PG8_BAR; PG8_MMA(0, 0, At, B0); PG8_MMA(0, 1, At, B1); PG8_BAR; PG8_SCHED;
            PG8_LDA(At, 0, 1); PG8_STAGE(PG8_SB(0, 0), b2, voffB); PG8_STAGE(PG8_SB(0, 1), b2 + hstep, voffB); PG8_STAGE(PG8_SA(0, 0), a2, voffA);
            PG8_WAIT_V(8); PG8_WAIT_L(0); PG8_BAR; PG8_MMA(1, 0, At, B0); PG8_MMA(1, 1, At, B1); PG8_BAR; PG8_SCHED;
            PG8_LDB(B0, 1, 0); PG8_LDB(B1, 1, 1); PG8_SCHED; PG8_LDA(At, 1, 0); PG8_STAGE(PG8_SA(0, 1), a2 + hstep, voffA);
            PG8_WAIT_V(8); PG8_WAIT_L(0); PG8_BAR; PG8_MMA(0, 0, At, B0); PG8_MMA(0, 1, At, B1); PG8_BAR; PG8_SCHED;
            PG8_LDA(At, 1, 1); PG8_STAGE(PG8_SB(1, 0), b3, voffB); PG8_STAGE(PG8_SB(1, 1), b3 + hstep, voffB); PG8_STAGE(PG8_SA(1, 0), a3, voffA);
            PG8_WAIT_V(8); PG8_WAIT_L(0); PG8_BAR; PG8_MMA(1, 0, At, B0); PG8_MMA(1, 1, At, B1); PG8_BAR; PG8_SCHED;
            } else {
            PG8_LDB(B0, 0, 0); PG8_SCHED; PG8_LDA(At, 0, 0); PG8_STAGE(PG8_SA(1, 1), a1 + hstep, voffA);
            PG8_WAIT_L(8); PG8_BAR; PG8_WAIT_L(0); PG8_MMA(0, 0, At, B0); PG8_BAR; PG8_SCHED;
            PG8_LDB(B1, 0, 1); PG8_STAGE(PG8_SB(0, 0), b2, voffB);
            PG8_BAR; PG8_WAIT_L(0); PG8_MMA(0, 1, At, B1); PG8_BAR;
            PG8_LDA(At, 0, 1); PG8_STAGE(PG8_SA(0, 0), a2, voffA);
            PG8_BAR; PG8_WAIT_L(0); PG8_MMA(1, 0, At, B0); PG8_BAR; PG8_SCHED;
            PG8_STAGE(PG8_SB(0, 1), b2 + hstep, voffB);
            PG8_WAIT_V(6); PG8_BAR; PG8_MMA(1, 1, At, B1); PG8_BAR;
            PG8_LDB(B0, 1, 0); PG8_SCHED; PG8_LDA(At, 1, 0); PG8_STAGE(PG8_SA(0, 1), a2 + hstep, voffA);
            PG8_WAIT_L(8); PG8_BAR; PG8_WAIT_L(0); PG8_MMA(0, 0, At, B0); PG8_BAR; PG8_SCHED;
            PG8_LDB(B1, 1, 1); PG8_STAGE(PG8_SB(1, 0), b3, voffB);
            PG8_BAR; PG8_WAIT_L(0); PG8_MMA(0, 1, At, B1); PG8_BAR;
            PG8_LDA(At, 1, 1); PG8_STAGE(PG8_SA(1, 0), a3, voffA);
            PG8_BAR; PG8_WAIT_L(0); PG8_MMA(1, 0, At, B0); PG8_BAR; PG8_SCHED;
            PG8_STAGE(PG8_SB(1, 1), b3 + hstep, voffB);
            PG8_WAIT_V(6); PG8_BAR; PG8_MMA(1, 1, At, B1); PG8_BAR;
            }
        }
        if constexpr (ALIGN_EPI) { if (wr == 0) PG8_BAR; }
        if constexpr (!Epi::AFTER_DRAIN) { E(acc, cur, wr, wc, fr, fq); S.done(cur); }
        if (!has_next) break;
#pragma unroll
        for (int a = 0; a < 2; ++a)
#pragma unroll
            for (int b = 0; b < 2; ++b)
#pragma unroll
                for (int m = 0; m < 4; ++m)
#pragma unroll
                    for (int n = 0; n < 2; ++n) acc[a][b][m][n] = (f32x4){0.f, 0.f, 0.f, 0.f};
        cur = nxt; cA = nA; cB = nB; ++ui;
        if constexpr (ALIGN_EPI) { if (wr == 1) PG8_BAR; }
    }
    PG8_WAIT_V(0);
    if constexpr (!ALIGN_EPI) { if (wr == 0) PG8_BAR; }
    PG8_BAR;
    if constexpr (Epi::AFTER_DRAIN) { E.fused(acc, cur, wr, wc, fr, fq, lds, wid, lane); S.done(cur); }
#undef PG8_SA
#undef PG8_SB
#undef PG8_STAGE
#undef PG8_LDA
#undef PG8_LDB
#undef PG8_MMA
#undef PG8_WAIT_V
#undef PG8_WAIT_L
#undef PG8_BAR
#undef PG8_SCHED
}
}

constexpr int SEQ = 16384, DM = 4096, DEPTH = 4, HYW = 2048, SSW = 2048, NHEAD = 32, HDIM = 64, NGRP = 8, NST = 128, QCH = 256, NCH = SEQ / QCH;
constexpr int NIN = 12320, DFF = 16384, XBCW = 4096, PSW = 6144, NTAP = 8192;
constexpr float EPS = 1e-5f;
enum { I_X = 0, I_NMG, I_WIN, I_HCW, I_HCB, I_PW1, I_PB1, I_PW2, I_PB2, I_PW3, I_PB3, I_SF, I_WOUTF, I_SKIP, I_HOG, I_SCW, I_SCB, I_ALOG, I_DTB, I_SD, I_SOG, I_WO, I_NLG, I_WUP, I_WDN, I_FNG, N_INPUTS };

constexpr size_t MiB = 1u << 20;
constexpr size_t WS_CTL = 0, CTL_ZERO_BYTES = 1 * MiB;
constexpr size_t WS_TW = 1 * MiB;
constexpr size_t WS_PW = WS_TW + 131072;
constexpr size_t WS_WIN = 2 * MiB;
constexpr size_t WS_WOUT = 100 * MiB;
constexpr size_t WS_WUP = 132 * MiB;
constexpr size_t WS_WDN = 260 * MiB;
constexpr size_t WS_XN = 388 * MiB;
constexpr size_t WS_PT = 516 * MiB;
constexpr size_t WS_PS = 708 * MiB;
constexpr size_t WS_XBC = 900 * MiB;
constexpr size_t WS_H3 = 1028 * MiB;
constexpr size_t WS_DTF = 1032 * MiB, WS_DTB = 1034 * MiB, WS_ACS = 1036 * MiB, WS_RB = 1038 * MiB, WS_SSQ = 1040 * MiB, WS_DTRAW = 1042 * MiB;
constexpr size_t WS_SSQA = 1028 * MiB + 2 * MiB, WS_SSQB = WS_SSQA + 65536;
constexpr size_t WS_PARTA = 2900 * MiB, WS_PARTB = 2904 * MiB;
constexpr size_t WS_HT = 1044 * MiB;
constexpr size_t WS_Z2T = 1556 * MiB;
constexpr size_t WS_S = 1684 * MiB;
constexpr size_t WS_SIN = 1812 * MiB;
constexpr size_t WS_YMIX = 1876 * MiB;
constexpr size_t WS_X = 2004 * MiB;
constexpr size_t WS_H = 2260 * MiB;
constexpr size_t WS_GSCR = 2772 * MiB;
constexpr size_t GSCR_PER_WG = 17 * 512 * 16 + 16 * 512 * 8;
constexpr size_t WS_DUMMY = 2912 * MiB;
constexpr size_t WS_END = 2908 * MiB;
constexpr int CW_BAR = 4096;

constexpr int LDS_BYTES = 163840;
constexpr int MISC_OFF = LDS_BYTES - 256;
constexpr int FFT_BYTES = (16384 + 512) * 8;
constexpr int RED_OFF = FFT_BYTES;

#define GAS __attribute__((address_space(1)))
#define LAS __attribute__((address_space(3)))
typedef unsigned short bf16;
typedef unsigned v4u __attribute__((ext_vector_type(4)));
typedef unsigned v2u __attribute__((ext_vector_type(2)));
typedef float f32x4 __attribute__((ext_vector_type(4)));
typedef float f32x2 __attribute__((ext_vector_type(2)));
typedef float f32x16 __attribute__((ext_vector_type(16)));
typedef short bf16x8 __attribute__((ext_vector_type(8)));
typedef short bf16x4 __attribute__((ext_vector_type(4)));
#define LDS_WAIT() asm volatile("s_waitcnt lgkmcnt(0)" ::: "memory")
__device__ __forceinline__ float bf2f(unsigned short h) { return __uint_as_float((unsigned)h << 16); }
__device__ __forceinline__ float bflo(unsigned w) { return __uint_as_float(w << 16); }
__device__ __forceinline__ float bfhi(unsigned w) { return __uint_as_float(w & 0xffff0000u); }
__device__ __forceinline__ unsigned pk2(float lo, float hi) { return pg8::cvt_pk_bf16(lo, hi); }
__device__ __forceinline__ float wave_sum(float v) {
#pragma unroll
    for (int o = 1; o < 64; o <<= 1) v += __shfl_xor(v, o);
    return v;
}
__device__ __forceinline__ float rdlane(float v, int l) { return __int_as_float(__builtin_amdgcn_readlane(__float_as_int(v), l)); }
__device__ __forceinline__ float silu_f(float x) { return x * __builtin_amdgcn_rcpf(1.0f + __expf(-x)); }
__device__ __forceinline__ float softplus_f(float x) { return fmaxf(x, 0.f) + log1pf(expf(-fabsf(x))); }

#define XB_TMO      128
#define XB_XCNT(j)  (256  + 64 * (j))
#define XB_XSUB(j)  (1280 + 64 * (j))
#define XB_XGEN(j)  (2304 + 64 * (j))
#define XB_TOP      3328
#define XB_TOPGEN   3392
#define XCD_BAR_WORDS 3456
#define XB_SPIN_CAP (1u << 18)

__device__ __forceinline__ unsigned xb_ld(unsigned* p)              { return __hip_atomic_load(p, __ATOMIC_RELAXED, __HIP_MEMORY_SCOPE_AGENT); }
__device__ __forceinline__ unsigned xb_add(unsigned* p, unsigned v) { return __hip_atomic_fetch_add(p, v, __ATOMIC_RELAXED, __HIP_MEMORY_SCOPE_AGENT); }
__device__ __forceinline__ unsigned xb_xcc_id() { return (unsigned)__builtin_amdgcn_s_getreg((3 << 11) | 20) & 0xFu; }
#define XB_SPIN(cond, bar) do { unsigned _sp = 0; while (cond) { __builtin_amdgcn_s_sleep(1); \
    if ((++_sp & 255u) == 0u) { if (xb_ld(&(bar)[XB_TMO])) break; if (_sp > XB_SPIN_CAP) { atomicAdd(&(bar)[XB_TMO], 1u); break; } } } } while (0)

struct XcdBarrier {
    unsigned* bar; unsigned x;
    volatile LAS unsigned* st;
};

__device__ __forceinline__ XcdBarrier xcd_barrier_post(unsigned* bar, volatile LAS unsigned* st) {
    XcdBarrier b; b.bar = bar; b.x = xb_xcc_id(); b.st = st;
    if (threadIdx.x == 0) (void)xb_add(&bar[XB_XCNT(b.x)], 1u);
    return b;
}
__device__ __forceinline__ void xcd_barrier_complete(unsigned* bar, unsigned x, unsigned& nloc, unsigned& nx) {
    const unsigned G = gridDim.x * gridDim.y * gridDim.z;
    unsigned sum, cnt, mine, sp = 0u;
    for (;;) {
        sum = 0u; cnt = 0u; mine = 0u;
#pragma unroll
        for (unsigned j = 0; j < 16; ++j) { const unsigned c = xb_ld(&bar[XB_XCNT(j)]); sum += c; cnt += (c > 0u) ? 1u : 0u; mine = (j == x) ? c : mine; }
        if (sum == G) break;
        __builtin_amdgcn_s_sleep(1);
        if ((++sp & 255u) == 0u) { if (xb_ld(&bar[XB_TMO])) break; if (sp > XB_SPIN_CAP) { atomicAdd(&bar[XB_TMO], 1u); break; } }
    }
    nloc = mine > 0u ? mine : 1u; nx = cnt > 0u ? cnt : 1u;
}

__device__ __forceinline__ void xcd_barrier(const XcdBarrier& b) {
    asm volatile("s_waitcnt vmcnt(0)" ::: "memory");
    __syncthreads();
    if (threadIdx.x == 0) {
        unsigned* bar = b.bar;
        __builtin_amdgcn_s_waitcnt(0);
        unsigned nloc = b.st[0], nx = b.st[1];
        if (nloc == 0u) { xcd_barrier_complete(bar, b.x, nloc, nx); b.st[0] = nloc; b.st[1] = nx; }
        const unsigned old = xb_add(&bar[XB_XSUB(b.x)], 1u);
        const unsigned gen = old / nloc;
        if (old + 1u == (gen + 1u) * nloc) {
            __builtin_amdgcn_fence(__ATOMIC_RELEASE, "agent");
            asm volatile("s_waitcnt vmcnt(0)" ::: "memory");
            const unsigned og = xb_add(&bar[XB_TOP], 1u);
            const unsigned tg = og / nx;
            if (og + 1u == (tg + 1u) * nx) xb_add(&bar[XB_TOPGEN], 1u);
            else XB_SPIN(xb_ld(&bar[XB_TOPGEN]) == tg, bar);
            __builtin_amdgcn_fence(__ATOMIC_ACQUIRE, "agent");
            xb_add(&bar[XB_XGEN(b.x)], 1u);
            asm volatile("s_waitcnt vmcnt(0)" ::: "memory");
        } else {
            XB_SPIN(xb_ld(&bar[XB_XGEN(b.x)]) == gen, bar);
            __builtin_amdgcn_fence(__ATOMIC_ACQUIRE, "agent");
            asm volatile("s_waitcnt vmcnt(0)" ::: "memory");
        }
    }
    __syncthreads();
}

__device__ __forceinline__ void transpose_item(const float* W, int K, int N, bf16* WT, LAS float* scr, int item, int lane, const float* gk) {
    const int nblk = N / 32, kb = item / nblk, nb = item % nblk, k0 = 64 * kb, n0 = 32 * nb;
#pragma unroll
    for (int i = 0; i < 32; ++i) { const int kk = 2 * i + (lane >> 5); scr[kk * 33 + (lane & 31)] = W[(size_t)(k0 + kk) * N + n0 + (lane & 31)]; }
    LDS_WAIT(); asm volatile("" ::: "memory");
    const int c = lane & 7;
    f32x4 g0 = (f32x4){1.f, 1.f, 1.f, 1.f}, g1 = g0;
    if (gk) { g0 = *(const f32x4*)(gk + k0 + 8 * c); g1 = *(const f32x4*)(gk + k0 + 8 * c + 4); }
#pragma unroll
    for (int j = 0; j < 4; ++j) { const int n = (lane >> 3) + 8 * j; const LAS float* s = scr + (8 * c) * 33 + n;
        v4u o; o.x = pk2(s[0 * 33] * g0.x, s[1 * 33] * g0.y); o.y = pk2(s[2 * 33] * g0.z, s[3 * 33] * g0.w); o.z = pk2(s[4 * 33] * g1.x, s[5 * 33] * g1.y); o.w = pk2(s[6 * 33] * g1.z, s[7 * 33] * g1.w);
        *(v4u*)(WT + (size_t)(n0 + n) * K + k0 + 8 * c) = o; }
    LDS_WAIT(); asm volatile("" ::: "memory");
}
template <bool TO_BF16>
__device__ __forceinline__ void rms_row(const float* xrow, const float* g, void* orow, int lane) {
    const f32x4* xr = (const f32x4*)xrow + lane;
    f32x4 v[16]; float s = 0.f;
#pragma unroll
    for (int j = 0; j < 16; ++j) { v[j] = xr[64 * j]; s += (v[j].x * v[j].x + v[j].y * v[j].y) + (v[j].z * v[j].z + v[j].w * v[j].w); }
    const float r = 1.0f / sqrtf(wave_sum(s) * (1.f / DM) + EPS);
    const f32x4* gr = (const f32x4*)g + lane;
#pragma unroll
    for (int j = 0; j < 16; ++j) { const f32x4 gg = gr[64 * j]; const f32x4 o = v[j] * r * gg;
        if (TO_BF16) { v2u w; w.x = pk2(o.x, o.y); w.y = pk2(o.z, o.w); ((v2u*)orow)[lane + 64 * j] = w; }
        else ((f32x4*)orow)[lane + 64 * j] = o; }
}
__device__ __forceinline__ void rms_row_b(const bf16* xrow, const float* g, float* orow, int lane) {
    const v4u* xr = (const v4u*)xrow + lane;
    v4u v[8]; float s = 0.f;
#pragma unroll
    for (int j = 0; j < 8; ++j) { v[j] = xr[64 * j];
#pragma unroll
        for (int e = 0; e < 4; ++e) { const float a = bflo(v[j][e]), b = bfhi(v[j][e]); s += a * a + b * b; } }
    const float r = 1.0f / sqrtf(wave_sum(s) * (1.f / DM) + EPS);
#pragma unroll
    for (int j = 0; j < 8; ++j) { const int c0 = (lane + 64 * j) * 8;
        const f32x4 g0 = *(const f32x4*)(g + c0), g1 = *(const f32x4*)(g + c0 + 4);
        f32x4 o0, o1;
        o0.x = bflo(v[j].x) * r * g0.x; o0.y = bfhi(v[j].x) * r * g0.y; o0.z = bflo(v[j].y) * r * g0.z; o0.w = bfhi(v[j].y) * r * g0.w;
        o1.x = bflo(v[j].z) * r * g1.x; o1.y = bfhi(v[j].z) * r * g1.y; o1.z = bflo(v[j].w) * r * g1.z; o1.w = bfhi(v[j].w) * r * g1.w;
        *(f32x4*)(orow + c0) = o0; *(f32x4*)(orow + c0 + 4) = o1; }
}
__device__ __forceinline__ void rstd_reduce(const float* part, float* rstd, int row) {
    float s = 0.f;
#pragma unroll 16
    for (int j = 0; j < 64; ++j) s += part[(size_t)j * SEQ + row];
    rstd[row] = pg8::rstd_of(s);
}
__device__ __forceinline__ void prep_row(const float* xrow, bf16* orow, float* rstd, int lane) {
    const f32x4* xr = (const f32x4*)xrow + lane; float s = 0.f;
#pragma unroll
    for (int j = 0; j < 16; ++j) { const f32x4 v = xr[64 * j]; s += (v.x * v.x + v.y * v.y) + (v.z * v.z + v.w * v.w); v2u w; w.x = pk2(v.x, v.y); w.y = pk2(v.z, v.w); ((v2u*)orow)[lane + 64 * j] = w; }
    s = wave_sum(s);
    if (lane == 0) *rstd = pg8::rstd_of(s);
}
__device__ __forceinline__ void posmlp_rows8(int t0, int ts, const float* w1, const float* b1, const float* w2, const float* b2, const float* w3, const float* b3, const float* sf, bf16* H3, int lane) {
    float zf[8], acc[8], h[8];
#pragma unroll
    for (int r = 0; r < 8; ++r) { const int t = t0 + r * ts;
        const float tl = (float)t / 16383.0f;
        const float wang = (6.283185307179586f * (float)t) / 16384.0f;
        float z = 0.f;
        if (lane == 0) z = tl;
        else if (lane <= 32) { const int i = (lane - 1) & 15; const float sfr = (float)i / 15.0f; const float f = 1e-4f * (1.0f - sfr) + 15.0f * sfr; const float ang = f * wang; z = (lane <= 16) ? cosf(ang) : -sinf(ang); }
        zf[r] = z; }
    { const float b = b1[lane];
#pragma unroll
      for (int r = 0; r < 8; ++r) acc[r] = b; }
#pragma unroll 3
    for (int f = 0; f < 33; ++f) { const float w = w1[f * 64 + lane];
#pragma unroll
        for (int r = 0; r < 8; ++r) acc[r] += rdlane(zf[r], f) * w; }
    { const float s_ = sf[lane], b = b2[lane];
#pragma unroll
      for (int r = 0; r < 8; ++r) { h[r] = sinf(s_ * acc[r]); acc[r] = b; } }
#pragma unroll 4
    for (int i = 0; i < 64; ++i) { const float w = w2[i * 64 + lane];
#pragma unroll
        for (int r = 0; r < 8; ++r) acc[r] += rdlane(h[r], i) * w; }
    { const float s_ = sf[64 + lane], b = b3[lane];
#pragma unroll
      for (int r = 0; r < 8; ++r) { h[r] = sinf(s_ * acc[r]); acc[r] = b; } }
#pragma unroll 4
    for (int i = 0; i < 64; ++i) { const float w = w3[i * 64 + lane];
#pragma unroll
        for (int r = 0; r < 8; ++r) acc[r] += rdlane(h[r], i) * w; }
    { const float s_ = sf[128 + lane];
#pragma unroll
      for (int r = 0; r < 8; ++r) { const int t = t0 + r * ts; const float o = sinf(s_ * acc[r]); if (t < SEQ) H3[(size_t)t * 64 + lane] = (bf16)(pk2(o, o) & 0xffffu); } }
}
__device__ __forceinline__ f32x4 mfma16_t(bf16x8 a, bf16x8 b, f32x4 c) { return __builtin_amdgcn_mfma_f32_16x16x32_bf16(a, b, c, 0, 0, 0); }
__device__ __forceinline__ void taps_gemm(const float* wout, const bf16* h3, bf16* HT, int gw, int NGW, int lane) {
    const int g = lane >> 4, li = lane & 15;
    const int ngroups = NGW / 256;
    if (ngroups == 0) return;
    const int nblk = gw % 256, tg = gw / 256;
    if (tg >= ngroups) return;
    const int n0 = 32 * nblk, steps_per = (SEQ / 16) / ngroups;
    const bool bwd = ((n0 >> 11) & 1) != 0;
    bf16x8 wf[2][2];
#pragma unroll
    for (int nt = 0; nt < 2; ++nt)
#pragma unroll
        for (int ks = 0; ks < 2; ++ks) { float w[8];
#pragma unroll
            for (int j = 0; j < 8; ++j) w[j] = wout[(size_t)(32 * ks + 8 * g + j) * NTAP + n0 + 16 * nt + li];
            v4u p; p.x = pk2(w[0], w[1]); p.y = pk2(w[2], w[3]); p.z = pk2(w[4], w[5]); p.w = pk2(w[6], w[7]); wf[nt][ks] = __builtin_bit_cast(bf16x8, p); }
    float ad[2];
#pragma unroll
    for (int nt = 0; nt < 2; ++nt) { const int c = (n0 + 16 * nt + li) & 2047; const float sfr = (float)c / 2047.0f;
        ad[nt] = fabsf(-120.39728043259361f * (1.0f - sfr) + 40.546510810816436f * sfr); }
    const int off = bwd ? 1 : 0;
    const int steps32 = (SEQ / 32) / ngroups;
    const int lrow = 8 * (li >> 2) + (li & 3);
#pragma unroll 2
    for (int i = 0; i < steps32; ++i) {
        const int t0 = 32 * (tg * steps32 + i);
        bf16x8 a[2][2];
#pragma unroll
        for (int tt = 0; tt < 2; ++tt) { const int trow = t0 + off + lrow + 4 * tt;
            const bf16x8* hr = (const bf16x8*)(h3 + (size_t)(trow < SEQ ? trow : SEQ - 1) * 64 + 8 * g); a[tt][0] = hr[0]; a[tt][1] = hr[4]; }
        const float tl0 = (float)(t0 + off + 8 * g) / 16383.0f;
#pragma unroll
        for (int nt = 0; nt < 2; ++nt) {
            float v[8];
#pragma unroll
            for (int tt = 0; tt < 2; ++tt) { f32x4 d = (f32x4){0.f, 0.f, 0.f, 0.f};
                d = mfma16_t(a[tt][0], wf[nt][0], d); d = mfma16_t(a[tt][1], wf[nt][1], d);
#pragma unroll
                for (int r = 0; r < 4; ++r) v[4 * tt + r] = d[r] * __expf(-(tl0 + (float)(4 * tt + r) / 16383.0f) * ad[nt]); }
            bf16* rowp = HT + (size_t)(n0 + 16 * nt + li) * SEQ;
            v4u o;
            if (!bwd) { o.x = pk2(v[0], v[1]); o.y = pk2(v[2], v[3]); o.z = pk2(v[4], v[5]); o.w = pk2(v[6], v[7]); *(v4u*)(rowp + t0 + 8 * g) = o; }
            else { if (t0 + 8 * g + 8 == SEQ) v[7] = 0.f;
                   o.x = pk2(v[7], v[6]); o.y = pk2(v[5], v[4]); o.z = pk2(v[3], v[2]); o.w = pk2(v[1], v[0]); *(v4u*)(rowp + (SEQ - t0 - 8 * g - 8)) = o; }
        }
    }
}

#define CMULV(xr, xi, br, bi) do { const float _t = (xr) * (br) - (xi) * (bi); (xi) = (xr) * (bi) + (xi) * (br); (xr) = _t; } while (0)
#define DFT4V(r0, i0, r1, i1, r2, i2, r3, i3) do { \
    const f32x2 t0r = (r0) + (r2), t0i = (i0) + (i2), t1r = (r0) - (r2), t1i = (i0) - (i2); \
    const f32x2 t2r = (r1) + (r3), t2i = (i1) + (i3), dr = (r1) - (r3), di = (i1) - (i3); \
    (r0) = t0r + t2r; (i0) = t0i + t2i; (r2) = t0r - t2r; (i2) = t0i - t2i; \
    (r1) = t1r + di; (i1) = t1i - dr; (r3) = t1r - di; (i3) = t1i + dr; } while (0)
#define CMULVV(xr, xi, br, bi) do { const f32x2 _t = (xr) * (br) - (xi) * (bi); (xi) = (xr) * (bi) + (xi) * (br); (xr) = _t; } while (0)
__device__ __forceinline__ void dft16(f32x2 (&ar)[16], f32x2 (&ai)[16]) {
    const float C1 = 0.92387953251128674f, S1 = 0.38268343236508977f, HH = 0.70710678118654752f;
#pragma unroll
    for (int n2 = 0; n2 < 4; ++n2) DFT4V(ar[n2], ai[n2], ar[4 + n2], ai[4 + n2], ar[8 + n2], ai[8 + n2], ar[12 + n2], ai[12 + n2]);
    CMULVV(ar[5], ai[5], C1, -S1);
    CMULVV(ar[9], ai[9], HH, -HH);
    CMULVV(ar[13], ai[13], S1, -C1);
    CMULVV(ar[6], ai[6], HH, -HH);
    { const f32x2 t = ar[10]; ar[10] = ai[10]; ai[10] = -t; }
    CMULVV(ar[14], ai[14], -HH, -HH);
    CMULVV(ar[7], ai[7], S1, -C1);
    CMULVV(ar[11], ai[11], -HH, -HH);
    CMULVV(ar[15], ai[15], -C1, S1);
#pragma unroll
    for (int k1 = 0; k1 < 4; ++k1) DFT4V(ar[4 * k1], ai[4 * k1], ar[4 * k1 + 1], ai[4 * k1 + 1], ar[4 * k1 + 2], ai[4 * k1 + 2], ar[4 * k1 + 3], ai[4 * k1 + 3]);
}
#define CMULT(xr, xi, br, bi) do { const auto _t = (xr) * (br) - (xi) * (bi); (xi) = (xr) * (bi) + (xi) * (br); (xr) = _t; } while (0)
template <class T>
__device__ __forceinline__ void twiddle16(f32x2 (&ar)[16], f32x2 (&ai)[16], T wr, T wi) {
    const T w2r = wr * wr - wi * wi, w2i = 2.f * wr * wi;
    const T w3r = w2r * wr - w2i * wi, w3i = w2r * wi + w2i * wr;
    const T w4r = w2r * w2r - w2i * w2i, w4i = 2.f * w2r * w2i;
    CMULT(ar[1], ai[1], wr, wi); CMULT(ar[2], ai[2], w2r, w2i); CMULT(ar[3], ai[3], w3r, w3i);
    T br = w4r, bi = w4i;
#pragma unroll
    for (int m = 1; m < 4; ++m) {
        CMULT(ar[4 * m], ai[4 * m], br, bi);
        { T tr = br, ti = bi; CMULT(tr, ti, wr, wi); CMULT(ar[4 * m + 1], ai[4 * m + 1], tr, ti); }
        { T tr = br, ti = bi; CMULT(tr, ti, w2r, w2i); CMULT(ar[4 * m + 2], ai[4 * m + 2], tr, ti); }
        { T tr = br, ti = bi; CMULT(tr, ti, w3r, w3i); CMULT(ar[4 * m + 3], ai[4 * m + 3], tr, ti); }
        CMULT(br, bi, w4r, w4i);
    }
}
constexpr int TWL_OFF = RED_OFF + 256;
__device__ __forceinline__ void fft_fill_twl(const f32x2* TW, const f32x2* PW, LAS unsigned char* lds, int tid) {
    LAS f32x2* twl = (LAS f32x2*)(lds + TWL_OFF);
    twl[tid] = PW[tid]; twl[512 + tid] = TW[16 * (tid & 31)]; twl[1024 + tid] = TW[tid];
}
__device__ __forceinline__ void radix32_combine(const f32x2 (&Dr)[16], const f32x2 (&Di)[16], f32x2 (&X)[32]) {
#pragma unroll
    for (int k = 0; k < 16; ++k) { const int s = 4 * (k & 3) + (k >> 2);
        const float cr = __builtin_cosf(6.28318530717958647692f * (float)k / 32.0f), ci = -__builtin_sinf(6.28318530717958647692f * (float)k / 32.0f);
        const float tr = cr * Dr[s].y - ci * Di[s].y, ti = cr * Di[s].y + ci * Dr[s].y;
        X[k] = (f32x2){Dr[s].x + tr, Di[s].x + ti}; X[k + 16] = (f32x2){Dr[s].x - tr, Di[s].x - ti}; }
}
__device__ __forceinline__ void fft16k(f32x2 (&Rr)[16], f32x2 (&Ri)[16], LAS f32x2* fb, const LAS f32x2* twl, int tid_in) {
    int tid = tid_in; asm volatile("" : "+v"(tid));
    const int j = tid;
    f32x2 X[32];
    __syncthreads();
    dft16(Rr, Ri);
    radix32_combine(Rr, Ri, X);
#pragma unroll
    for (int k = 0; k < 32; ++k) fb[33 * j + k] = X[k];
    __syncthreads();
    {
        const f32x2 w = twl[512 + tid];
#pragma unroll
        for (int s = 0; s < 16; ++s) { const f32x2 v0 = fb[j + (j >> 5) + 528 * (2 * s)], v1 = fb[j + (j >> 5) + 528 * (2 * s + 1)]; Rr[s] = (f32x2){v0.x, v1.x}; Ri[s] = (f32x2){v0.y, v1.y}; }
        const float w2r = w.x * w.x - w.y * w.y, w2i = 2.f * w.x * w.y;
        twiddle16<float>(Rr, Ri, w2r, w2i);
        const f32x2 ur = (f32x2){1.f, w.x}, ui = (f32x2){0.f, w.y};
#pragma unroll
        for (int s = 0; s < 16; ++s) CMULT(Rr[s], Ri[s], ur, ui);
        dft16(Rr, Ri);
        radix32_combine(Rr, Ri, X);
    }
    __syncthreads();
#pragma unroll
    for (int k = 0; k < 32; ++k) fb[(j >> 5) * 1056 + (j & 31) + 33 * k] = X[k];
    __syncthreads();
    {
        const f32x2 w0 = twl[1024 + tid];
        const float c16 = 0.98078528040323043f, s16 = 0.19509032201612825f;
        const f32x2 wr = (f32x2){w0.x, w0.x * c16 + w0.y * s16}, wi = (f32x2){w0.y, w0.y * c16 - w0.x * s16};
#pragma unroll
        for (int r = 0; r < 16; ++r) { const f32x2 v0 = fb[j + (j >> 5) + 1056 * r], v1 = fb[j + (j >> 5) + 528 + 1056 * r]; Rr[r] = (f32x2){v0.x, v1.x}; Ri[r] = (f32x2){v0.y, v1.y}; }
        twiddle16<f32x2>(Rr, Ri, wr, wi);
        dft16(Rr, Ri);
#pragma unroll
        for (int k = 0; k < 16; ++k) { const int s = 4 * (k & 3) + (k >> 2); if (k < s) { const f32x2 tr = Rr[k], ti = Ri[k]; Rr[k] = Rr[s]; Ri[k] = Ri[s]; Rr[s] = tr; Ri[s] = ti; } }
    }
}
typedef unsigned v3u_a4 __attribute__((ext_vector_type(3), aligned(4)));
struct ConvRaw { unsigned lo, hi, nx; };
__device__ __forceinline__ ConvRaw conv_load(const bf16* row, int m) {
    const v3u_a4 v = *(const v3u_a4*)(row + (m > 0 ? 2 * m - 2 : 0));
    ConvRaw r; r.lo = (m > 0) ? v.x : 0u; r.hi = (m > 0) ? v.y : v.x;
    const unsigned n3 = (m > 0) ? v.z : v.y;
    r.nx = (m < SEQ / 2 - 1) ? (n3 & 0xffffu) : 0u;
    return r;
}
__device__ __forceinline__ void conv_apply(const ConvRaw& r, float w0, float w1, float w2, float b, float& u0, float& u1) {
    const float pm = bfhi(r.lo), p0 = bflo(r.hi), p1 = bfhi(r.hi), pp = __uint_as_float(r.nx << 16);
    u0 = w0 * pm + w1 * p0 + w2 * p1 + b; u1 = w0 * p0 + w1 * p1 + w2 * pp + b;
}
#define FFT_CALL() do { f32x2 Rr_[16], Ri_[16]; \
    _Pragma("unroll") for (int e_ = 0; e_ < 16; ++e_) { Rr_[e_] = (f32x2){re[2 * e_], re[2 * e_ + 1]}; Ri_[e_] = (f32x2){im[2 * e_], im[2 * e_ + 1]}; } \
    fft16k(Rr_, Ri_, fb, TW, tid_in); \
    _Pragma("unroll") for (int e_ = 0; e_ < 16; ++e_) { re[2 * e_] = Rr_[e_].x; re[2 * e_ + 1] = Rr_[e_].y; im[2 * e_] = Ri_[e_].x; im[2 * e_ + 1] = Ri_[e_].y; } } while (0)
__device__ __forceinline__ f32x2 pw_q(f32x2 wt, int q) {
    const float cr = __builtin_cosf(3.14159265358979323846f * (float)q / 32.0f), ci = -__builtin_sinf(3.14159265358979323846f * (float)q / 32.0f);
    return (f32x2){wt.x * cr - wt.y * ci, wt.x * ci + wt.y * cr};
}
__device__ __forceinline__ void hyena_channel(int c, const bf16* PT, const bf16* HT, const float* cw, const float* cb, const float* skip, bf16* Z2T,
                                              f32x4* gscr, LAS unsigned char* lds, int tid_in) {
#define RETID() int tid = tid_in; asm volatile("" : "+v"(tid))
    LAS f32x2* fb = (LAS f32x2*)lds;
    LAS float* red = (LAS float*)(lds + RED_OFF);
    const LAS f32x2* TW = (const LAS f32x2*)(lds + TWL_OFF);
    const int lane = tid_in & 63, wave = tid_in >> 6;
    float sr[16], si[16];
    {
        RETID();
        const int col = 2 * HYW + c; const float w0 = cw[col], w1 = cw[3 * HYW + col], w2 = cw[6 * HYW + col], b = cb[col];
        const bf16* row = PT + (size_t)col * SEQ;
#pragma unroll
        for (int q = 0; q < 16; ++q) { const ConvRaw r = conv_load(row, tid + 512 * q); conv_apply(r, w0, w1, w2, b, sr[q], si[q]); }
    }
#pragma unroll 1
    for (int o = 0; o < 2; ++o) {
        float re[32], im[32];
        float Agr[17], Agi[17], Bgr[17], Bgi[17];
        {
            RETID();
            const bf16* hf = HT + (size_t)(o * 4096 + c) * SEQ;
            const bf16* hb = HT + (size_t)(o * 4096 + 2048 + c) * SEQ;
            float l1 = 0.f;
#pragma unroll
            for (int q = 0; q < 32; ++q) { const int m = tid + 512 * q;
                const unsigned w = (q < 16) ? *(const unsigned*)(hf + 2 * m) : *(const unsigned*)(hb + 2 * m - SEQ);
                re[q] = bflo(w); im[q] = bfhi(w); l1 += fabsf(re[q]) + fabsf(im[q]); }
            l1 = wave_sum(l1);
            __syncthreads();
            if (lane == 0) red[wave] = l1;
            __syncthreads();
            float tot = 0.f;
#pragma unroll
            for (int w = 0; w < 8; ++w) tot += red[w];
            const float scale = 1.0f / (8.0f * (float)SEQ * tot);
            FFT_CALL();
            __syncthreads();
          { RETID();
#pragma unroll
            for (int q = 0; q < 32; ++q) fb[tid + (tid >> 5) + 528 * q] = (f32x2){re[q], im[q]}; }
            __syncthreads();
          { RETID(); const f32x2 wt = TW[tid];
#pragma unroll
            for (int q = 0; q < 17; ++q) {
                const int k = tid + 512 * q;
                if (q < 16 || tid == 0) {
                    const int kp = (SEQ - k) & (SEQ - 1);
                    f32x2 zk; if (q < 16) zk = (f32x2){re[q], im[q]}; else zk = fb[(SEQ / 2) + (SEQ / 64)];
                    const f32x2 zp = fb[kp + (kp >> 5)];
                    const f32x2 w = (q < 16) ? pw_q(wt, q) : (f32x2){0.f, -1.f};
                    const float er = zk.x + zp.x, ei = zk.y - zp.y, orr = zk.y + zp.y, oi = zp.x - zk.x;
                    const float wor = w.x * orr - w.y * oi, woi = w.x * oi + w.y * orr;
                    Agr[q] = (er + wor) * scale; Agi[q] = (ei + woi) * scale; Bgr[q] = (er - wor) * scale; Bgi[q] = (ei - woi) * scale;
                } else { Agr[q] = 0.f; Agi[q] = 0.f; Bgr[q] = 0.f; Bgi[q] = 0.f; }
            } }
        }
#pragma unroll
        for (int q = 0; q < 16; ++q) { re[q] = sr[q]; im[q] = si[q]; re[q + 16] = 0.f; im[q + 16] = 0.f; }
        FFT_CALL();
        __syncthreads();
      { RETID();
#pragma unroll
        for (int q = 0; q < 32; ++q) fb[tid + (tid >> 5) + 528 * q] = (f32x2){re[q], im[q]}; }
        __syncthreads();
      { RETID(); const f32x2 wt = TW[tid];
#pragma unroll
        for (int q = 0; q < 17; ++q) {
            const int k = tid + 512 * q;
            if (q < 16 || tid == 0) {
                const int kp = (SEQ - k) & (SEQ - 1);
                f32x2 zk; if (q < 16) zk = (f32x2){re[q], im[q]}; else zk = fb[(SEQ / 2) + (SEQ / 64)];
                const f32x2 zp = fb[kp + (kp >> 5)];
                const f32x2 w = (q < 16) ? pw_q(wt, q) : (f32x2){0.f, -1.f};
                const float er = zk.x + zp.x, ei = zk.y - zp.y, orr = zk.y + zp.y, oi = zp.x - zk.x;
                const float wor = w.x * orr - w.y * oi, woi = w.x * oi + w.y * orr;
                const float ar = er + wor, ai = ei + woi, br = er - wor, bi = ei - woi;
                const float aar = ar * Agr[q] - ai * Agi[q], aai = ar * Agi[q] + ai * Agr[q];
                const float bbr = br * Bgr[q] - bi * Bgi[q], bbi = br * Bgi[q] + bi * Bgr[q];
                const float eyr = aar + bbr, eyi = aai + bbi, dyr = aar - bbr, dyi = aai - bbi;
                const float oyr = dyr * w.x + dyi * w.y, oyi = dyi * w.x - dyr * w.y;
                if (q < 16) { re[q] = eyr - oyi; im[q] = -eyi - oyr; fb[kp + (kp >> 5)] = (f32x2){eyr + oyi, eyi - oyr}; }
                else fb[(SEQ / 2) + (SEQ / 64)] = (f32x2){eyr - oyi, -eyi - oyr};
            }
        } }
        __syncthreads();
      { RETID();
#pragma unroll
        for (int q = 16; q < 32; ++q) { const f32x2 v = fb[tid + (tid >> 5) + 528 * q]; re[q] = v.x; im[q] = v.y; } }
        ConvRaw graw[16];
      { RETID(); const bf16* grow = PT + (size_t)(o * HYW + c) * SEQ;
#pragma unroll
        for (int q = 0; q < 16; ++q) graw[q] = conv_load(grow, tid + 512 * q); }
        FFT_CALL();
        {
            RETID();
            const int col = o * HYW + c; const float w0 = cw[col], w1 = cw[3 * HYW + col], w2 = cw[6 * HYW + col], b = cb[col];
            const float sk = skip[o * HYW + c]; bf16* orow = Z2T + (size_t)c * SEQ;
#pragma unroll
            for (int q = 0; q < 16; ++q) { float g0, g1; conv_apply(graw[q], w0, w1, w2, b, g0, g1);
                const float o0 = g0 * (re[q] + sk * sr[q]), o1 = g1 * (-im[q] + sk * si[q]);
                sr[q] = o0; si[q] = o1;
                if (o == 1) *(unsigned*)(orow + 2 * (tid + 512 * q)) = pk2(o0, o1); }
        }
    }
#undef RETID
}

typedef unsigned short u16;
__device__ __forceinline__ f32x4 mfma16(bf16x8 a, bf16x8 b, f32x4 c) { return __builtin_amdgcn_mfma_f32_16x16x32_bf16(a, b, c, 0, 0, 0); }

__device__ __forceinline__ void ssm_conv_item(const bf16* __restrict__ PS, const float* cw, const float* cb, bf16* __restrict__ XBC, int item) {
    const int oct = item & 511, rb = item >> 9, ch = 8 * oct, t0 = 32 * rb;
    float w0[8], w1[8], w2[8], bb[8];
#pragma unroll
    for (int e = 0; e < 8; ++e) { w0[e] = cw[ch + e]; w1[e] = cw[XBCW + ch + e]; w2[e] = cw[2 * XBCW + ch + e]; bb[e] = cb[ch + e]; }
    const bf16* src = PS + 2048 + ch;
    v4u prev = (v4u){0u, 0u, 0u, 0u}, cur;
    if (t0 > 0) prev = *(const v4u*)(src + (size_t)(t0 - 1) * PSW);
    cur = *(const v4u*)(src + (size_t)t0 * PSW);
#pragma unroll 1
    for (int r8 = 0; r8 < 32; r8 += 8) {
        v4u nx[8];
#pragma unroll
        for (int i = 0; i < 8; ++i) { const int t = t0 + r8 + i + 1; nx[i] = (v4u){0u, 0u, 0u, 0u}; if (t < SEQ) nx[i] = *(const v4u*)(src + (size_t)t * PSW); }
#pragma unroll
        for (int i = 0; i < 8; ++i) {
            const v4u nxt = nx[i];
            float o[8];
#pragma unroll
            for (int e = 0; e < 4; ++e) {
                const unsigned pw = prev[e], cwd = cur[e], nw = nxt[e];
                const float x0 = w0[2 * e] * bflo(pw) + w1[2 * e] * bflo(cwd) + w2[2 * e] * bflo(nw) + bb[2 * e];
                const float x1 = w0[2 * e + 1] * bfhi(pw) + w1[2 * e + 1] * bfhi(cwd) + w2[2 * e + 1] * bfhi(nw) + bb[2 * e + 1];
                o[2 * e] = silu_f(x0); o[2 * e + 1] = silu_f(x1);
            }
            v4u ov; ov.x = pk2(o[0], o[1]); ov.y = pk2(o[2], o[3]); ov.z = pk2(o[4], o[5]); ov.w = pk2(o[6], o[7]);
            *(v4u*)(XBC + (size_t)(t0 + r8 + i) * XBCW + ch) = ov;
            prev = cur; cur = nxt;
        }
    }
}
__device__ __forceinline__ void ssm_dt_tile(int tile, const bf16* XN, const bf16* Wdt, const float* rstd, float* DTRAW, int lane) {
    const int li = lane & 15, g = lane >> 4, t0 = 16 * tile;
    f32x4 acc0 = (f32x4){0.f, 0.f, 0.f, 0.f}, acc1 = (f32x4){0.f, 0.f, 0.f, 0.f};
    const bf16* xa = XN + (size_t)(t0 + li) * DM + 8 * g;
    const bf16* wb0 = Wdt + (size_t)li * DM + 8 * g;
    const bf16* wb1 = wb0 + (size_t)16 * DM;
#pragma unroll 8
    for (int ks = 0; ks < DM / 32; ++ks) {
        const bf16x8 a = *(const bf16x8*)(xa + 32 * ks), b0 = *(const bf16x8*)(wb0 + 32 * ks), b1 = *(const bf16x8*)(wb1 + 32 * ks);
        acc0 = mfma16(a, b0, acc0); acc1 = mfma16(a, b1, acc1);
    }
#pragma unroll
    for (int r = 0; r < 4; ++r) { const float rs = rstd[t0 + 4 * g + r];
        DTRAW[(size_t)(t0 + 4 * g + r) * 32 + li] = acc0[r] * rs; DTRAW[(size_t)(t0 + 4 * g + r) * 32 + 16 + li] = acc1[r] * rs; }
}
constexpr int XT_STRIDE = 264;
constexpr int BM_STRIDE = 136;
constexpr int SSD_XT_OFF = 0, SSD_BM_OFF = 64 * XT_STRIDE * 2  , SSD_ARR_OFF = SSD_BM_OFF + 256 * BM_STRIDE * 2  , SSD_SIN_OFF = SSD_ARR_OFF + 4096  ;
static_assert(SSD_SIN_OFF + 2 * 64 * BM_STRIDE * 2 + 4 * (512 + 32) <= MISC_OFF, "SSD LDS map");
__device__ __forceinline__ void ssd_stage_xb(int c, int h, const bf16* XBC, LAS unsigned char* lds, int tid, bool newB) {
    LAS u16* XT = (LAS u16*)(lds + SSD_XT_OFF);
    LAS u16* Bm = (LAS u16*)(lds + SSD_BM_OFF);
    const int t0 = c * QCH, grp = h >> 2;
#pragma unroll
    for (int i = 0; i < 4; ++i) { const int id = tid + 512 * i, s = id & 255, pc = id >> 8;
        const v4u v = *(const v4u*)(XBC + (size_t)(t0 + s) * XBCW + h * HDIM + 8 * pc);
        const bool odd = (s & 1) != 0;
        const unsigned sx = odd ? v.x : v.z, sy = odd ? v.y : v.w;
        const unsigned rx = (unsigned)__builtin_amdgcn_update_dpp(0, (int)sx, 0xB1, 0xF, 0xF, true), ry = (unsigned)__builtin_amdgcn_update_dpp(0, (int)sy, 0xB1, 0xF, 0xF, true);
        const unsigned ex = odd ? rx : v.x, ey = odd ? ry : v.y;
        const unsigned ox = odd ? v.z : rx, oy = odd ? v.w : ry;
        const int c0 = 8 * pc + (odd ? 4 : 0), se = s & ~1;
        *(LAS unsigned*)(XT + (c0 + 0) * XT_STRIDE + se) = (ex & 0xffffu) | (ox << 16);
        *(LAS unsigned*)(XT + (c0 + 1) * XT_STRIDE + se) = (ex >> 16) | (ox & 0xffff0000u);
        *(LAS unsigned*)(XT + (c0 + 2) * XT_STRIDE + se) = (ey & 0xffffu) | (oy << 16);
        *(LAS unsigned*)(XT + (c0 + 3) * XT_STRIDE + se) = (ey >> 16) | (oy & 0xffff0000u); }
    if (newB) {
#pragma unroll
    for (int i = 0; i < 8; ++i) { const int id = tid + 512 * i, s = id >> 4, nc = id & 15;
        const v4u v = *(const v4u*)(XBC + (size_t)(t0 + s) * XBCW + SSW + grp * NST + 8 * nc);
        *(LAS v4u*)(Bm + s * BM_STRIDE + 8 * nc) = v; }
    }
}
__device__ __forceinline__ void ssd_states_unit(int c, int h_in, const bf16* XBC, const float* DTRAW, const float* alog, const float* dtbias, float* DTF, float* DTB, float* ACS, float* RB, bf16* S,
                                                LAS unsigned char* lds, int tid, bool newB) {
    const int lane = tid & 63, wave = tid >> 6, li = lane & 15, g = lane >> 4;
    LAS u16* XT = (LAS u16*)(lds + SSD_XT_OFF);
    LAS u16* Bm = (LAS u16*)(lds + SSD_BM_OFF);
    LAS float* wfa = (LAS float*)(lds + SSD_ARR_OFF);
    const int t0 = c * QCH;
    __syncthreads();
    ssd_stage_xb(c, h_in, XBC, lds, tid, newB);
    if (newB) {
        const int dir = wave & 1; const int hq = wave >> 1;
        LAS float* wf = wfa + hq * 512; LAS float* wb = wf + 256;
        const int h = (h_in & ~3) + hq;
        const float A = -expf(alog[dir * 32 + h]), bias = dtbias[dir * 32 + h];
        float dtv[4], inc[4];
#pragma unroll
        for (int e = 0; e < 4; ++e) dtv[e] = softplus_f(DTRAW[(size_t)(t0 + 4 * lane + e) * 32 + h] + bias);
        inc[0] = dtv[0] * A; inc[1] = inc[0] + dtv[1] * A; inc[2] = inc[1] + dtv[2] * A; inc[3] = inc[2] + dtv[3] * A;
        float sc = inc[3];
#pragma unroll
        for (int o = 1; o < 64; o <<= 1) { const float t = __shfl_up(sc, o); if (lane >= o) sc += t; }
        const float excl = sc - inc[3], total = rdlane(sc, 63);
#pragma unroll
        for (int e = 0; e < 4; ++e) { const int tl = 4 * lane + e; const size_t o = (size_t)(t0 + tl) * 32 + h; const float ic = excl + inc[e];
            if (dir == 0) { wf[tl] = __expf(total - ic) * dtv[e]; DTF[o] = dtv[e]; ACS[o] = ic; }
            else { const float pre = ic - dtv[e] * A; wb[tl] = __expf(pre) * dtv[e]; DTB[o] = dtv[e]; RB[o] = total - pre; } }
    }
    const int h = h_in;
    const LAS float* wf = wfa + (h & 3) * 512; const LAS float* wb = wf + 256;
    __syncthreads();
    f32x4 acc[2][4];
#pragma unroll
    for (int d = 0; d < 2; ++d)
#pragma unroll
        for (int p = 0; p < 4; ++p) acc[d][p] = (f32x4){0.f, 0.f, 0.f, 0.f};
    const int n = 16 * wave + li;
#pragma unroll 2
    for (int ks = 0; ks < 8; ++ks) {
        const int s0 = 32 * ks + 8 * g;
        float bv[8];
#pragma unroll
        for (int j = 0; j < 8; ++j) bv[j] = bf2f(Bm[(s0 + j) * BM_STRIDE + n]);
        const f32x4 wf0 = *(const LAS f32x4*)(wf + s0), wf1 = *(const LAS f32x4*)(wf + s0 + 4), wb0 = *(const LAS f32x4*)(wb + s0), wb1 = *(const LAS f32x4*)(wb + s0 + 4);
        v4u fa, fbk;
        fa.x = pk2(bv[0] * wf0.x, bv[1] * wf0.y); fa.y = pk2(bv[2] * wf0.z, bv[3] * wf0.w); fa.z = pk2(bv[4] * wf1.x, bv[5] * wf1.y); fa.w = pk2(bv[6] * wf1.z, bv[7] * wf1.w);
        fbk.x = pk2(bv[0] * wb0.x, bv[1] * wb0.y); fbk.y = pk2(bv[2] * wb0.z, bv[3] * wb0.w); fbk.z = pk2(bv[4] * wb1.x, bv[5] * wb1.y); fbk.w = pk2(bv[6] * wb1.z, bv[7] * wb1.w);
        const bf16x8 af = __builtin_bit_cast(bf16x8, fa), ab = __builtin_bit_cast(bf16x8, fbk);
#pragma unroll
        for (int pt = 0; pt < 4; ++pt) {
            const bf16x8 xf = *(const LAS bf16x8*)(XT + (16 * pt + li) * XT_STRIDE + s0);
            acc[0][pt] = mfma16(af, xf, acc[0][pt]); acc[1][pt] = mfma16(ab, xf, acc[1][pt]);
        }
    }
#pragma unroll
    for (int d = 0; d < 2; ++d) { bf16* So = S + ((size_t)(c * 2 + d) * NHEAD + h) * (HDIM * NST);
#pragma unroll
        for (int pt = 0; pt < 4; ++pt) { v2u o; o.x = pk2(acc[d][pt][0], acc[d][pt][1]); o.y = pk2(acc[d][pt][2], acc[d][pt][3]); *(v2u*)(So + (16 * pt + li) * NST + 16 * wave + 4 * g) = o; } }
}
__device__ __forceinline__ void ssd_scan_item(int e4, const bf16* S, const float* ACS, const float* RB, bf16* SIN) {
    const int e = 4 * e4, dir = e / (NHEAD * HDIM * NST), h = (e / (HDIM * NST)) % NHEAD;
    const size_t cs = (size_t)2 * NHEAD * HDIM * NST;
    f32x4 st = (f32x4){0.f, 0.f, 0.f, 0.f};
#pragma unroll 1
    for (int c0 = 0; c0 < NCH; c0 += 16) {
        v2u sv[16]; float tv[16];
#pragma unroll
        for (int i = 0; i < 16; ++i) { const int c = dir ? (NCH - 1 - (c0 + i)) : (c0 + i);
            sv[i] = *(const v2u*)(S + c * cs + e);
            tv[i] = dir ? RB[(size_t)(c * QCH) * 32 + h] : ACS[(size_t)(c * QCH + QCH - 1) * 32 + h]; }
#pragma unroll
        for (int i = 0; i < 16; ++i) { const int c = dir ? (NCH - 1 - (c0 + i)) : (c0 + i);
            v2u o; o.x = pk2(st.x, st.y); o.y = pk2(st.z, st.w); *(v2u*)(SIN + c * cs + e) = o;
            const f32x4 sc = (f32x4){__uint_as_float(sv[i].x << 16), __uint_as_float(sv[i].x & 0xffff0000u), __uint_as_float(sv[i].y << 16), __uint_as_float(sv[i].y & 0xffff0000u)};
            st = st * __expf(tv[i]) + sc; }
    }
}
__device__ __forceinline__ void ssd_out_unit(int c, int h, const bf16* XBC, const bf16* PS, const float* DTF, const float* DTB, const float* ACS, const float* RB, const bf16* SIN,
                                             float Dskip, bf16* YMIX, float* SSQ, LAS unsigned char* lds, int tid, bool newB) {
    const int lane = tid & 63, wave = tid >> 6, li = lane & 15, g = lane >> 4;
    LAS u16* XT = (LAS u16*)(lds + SSD_XT_OFF);
    LAS u16* Bm = (LAS u16*)(lds + SSD_BM_OFF);
    LAS float* acsL = (LAS float*)(lds + SSD_ARR_OFF);
    LAS float* rbL = acsL + 256; LAS float* dtfL = acsL + 512; LAS float* dtbL = acsL + 768;
    LAS float* cfL = (LAS float*)(lds + SSD_SIN_OFF + 2 * 64 * BM_STRIDE * 2); LAS float* cbL = cfL + 256; LAS float* rfL = cbL + 256; LAS float* rbfL = rfL + 16;
    LAS u16* SF = (LAS u16*)(lds + SSD_SIN_OFF);
    LAS u16* SB = SF + 64 * BM_STRIDE;
    const int t0 = c * QCH, grp = h >> 2;
    __syncthreads();
    ssd_stage_xb(c, h, XBC, lds, tid, newB);
    if (tid < 256) { const size_t o = (size_t)(t0 + tid) * 32 + h; const float LG2E = 1.44269504088896341f;
        const float a_ = ACS[o] * LG2E, r_ = RB[o] * LG2E, df_ = DTF[o], db_ = DTB[o];
        acsL[tid] = a_; rbL[tid] = r_; dtfL[tid] = df_; dtbL[tid] = db_;
        const float rff = ACS[(size_t)(t0 + (tid | 15)) * 32 + h] * LG2E, rfb = RB[(size_t)(t0 + (tid & ~15)) * 32 + h] * LG2E;
        cfL[tid] = __builtin_amdgcn_exp2f(rff - a_) * df_; cbL[tid] = __builtin_amdgcn_exp2f(rfb - r_) * db_;
        if ((tid & 15) == 0) { rfL[tid >> 4] = rff; rbfL[tid >> 4] = rfb; } }
    {
        const bf16* sf = SIN + ((size_t)(c * 2 + 0) * NHEAD + h) * (HDIM * NST);
        const bf16* sb = SIN + ((size_t)(c * 2 + 1) * NHEAD + h) * (HDIM * NST);
#pragma unroll
        for (int i = 0; i < 2; ++i) { const int id = tid + 512 * i, p = id >> 4, nc = id & 15;
            *(LAS v4u*)(SF + p * BM_STRIDE + 8 * nc) = *(const v4u*)(sf + p * NST + 8 * nc);
            *(LAS v4u*)(SB + p * BM_STRIDE + 8 * nc) = *(const v4u*)(sb + p * NST + 8 * nc); }
    }
    bf16x8 cfa[2][4];
#pragma unroll
    for (int lt = 0; lt < 2; ++lt)
#pragma unroll
        for (int kn = 0; kn < 4; ++kn) cfa[lt][kn] = *(const bf16x8*)(XBC + (size_t)(t0 + 32 * wave + 16 * lt + li) * XBCW + SSW + NGRP * NST + grp * NST + 32 * kn + 8 * g);
    __syncthreads();
#pragma unroll
    for (int lt = 0; lt < 2; ++lt) {
        const int l = 32 * wave + 16 * lt + li;
        bf16x8 cf[4];
#pragma unroll
        for (int kn = 0; kn < 4; ++kn) cf[kn] = cfa[lt][kn];
        v2u xwp[4], zwp[4];
#pragma unroll
        for (int pt = 0; pt < 4; ++pt) { xwp[pt] = *(const v2u*)(XBC + (size_t)(t0 + l) * XBCW + h * HDIM + 16 * pt + 4 * g); zwp[pt] = *(const v2u*)(PS + (size_t)(t0 + l) * PSW + h * HDIM + 16 * pt + 4 * g); }
        const float acs_l = acsL[l], rb_l = rbL[l];
        const int jl = __builtin_amdgcn_readfirstlane(2 * wave + lt);
        f32x4 yacc[4];
#pragma unroll
        for (int pt = 0; pt < 4; ++pt) yacc[pt] = (f32x4){0.f, 0.f, 0.f, 0.f};
#pragma unroll 2
        for (int ks = 0; ks < 8; ++ks) {
            bf16x8 bfr[2][4];
#pragma unroll
            for (int st = 0; st < 2; ++st)
#pragma unroll
                for (int kn = 0; kn < 4; ++kn) bfr[st][kn] = *(const LAS bf16x8*)(Bm + (32 * ks + 16 * st + li) * BM_STRIDE + 32 * kn + 8 * g);
            f32x4 cf4[2], cb4[2];
#pragma unroll
            for (int st = 0; st < 2; ++st) { const int s4 = 32 * ks + 16 * st + 4 * g; cf4[st] = *(const LAS f32x4*)(cfL + s4); cb4[st] = *(const LAS f32x4*)(cbL + s4); }
            v2u x0[4], x1[4];
#pragma unroll
            for (int pt = 0; pt < 4; ++pt) { const LAS u16* xr = XT + (16 * pt + li) * XT_STRIDE + 32 * ks + 4 * g; x0[pt] = *(const LAS v2u*)xr; x1[pt] = *(const LAS v2u*)(xr + 16); }
            f32x4 d[2] = {(f32x4){0.f, 0.f, 0.f, 0.f}, (f32x4){0.f, 0.f, 0.f, 0.f}};
#pragma unroll
            for (int kn = 0; kn < 4; ++kn) { d[0] = mfma16(bfr[0][kn], cf[kn], d[0]); d[1] = mfma16(bfr[1][kn], cf[kn], d[1]); }
            unsigned mw[4];
#pragma unroll
            for (int st = 0; st < 2; ++st) {
                const int s4 = 32 * ks + 16 * st + 4 * g;
                float mv[4];
                const int jt = 2 * ks + st;
                if (jt < jl) {
                    const float rw = __builtin_amdgcn_exp2f(acs_l - rfL[jt]);
#pragma unroll
                    for (int r = 0; r < 4; ++r) mv[r] = (d[st][r] * rw) * cf4[st][r];
                } else if (jt > jl) {
                    const float rw = __builtin_amdgcn_exp2f(rb_l - rbfL[jt]);
#pragma unroll
                    for (int r = 0; r < 4; ++r) mv[r] = (d[st][r] * rw) * cb4[st][r];
                } else {
                    const f32x4 as4 = *(const LAS f32x4*)(acsL + s4), rs4 = *(const LAS f32x4*)(rbL + s4), df4 = *(const LAS f32x4*)(dtfL + s4), db4 = *(const LAS f32x4*)(dtbL + s4);
#pragma unroll
                    for (int r = 0; r < 4; ++r) { const int s = s4 + r;
                        const float wfw = (s <= l) ? __builtin_amdgcn_exp2f(acs_l - as4[r]) * df4[r] : 0.f;
                        const float wbw = (s >= l) ? __builtin_amdgcn_exp2f(rb_l - rs4[r]) * db4[r] : 0.f;
                        mv[r] = d[st][r] * (wfw + wbw); }
                }
                mw[2 * st] = pk2(mv[0], mv[1]); mw[2 * st + 1] = pk2(mv[2], mv[3]);
            }
            v4u mfv; mfv.x = mw[0]; mfv.y = mw[1]; mfv.z = mw[2]; mfv.w = mw[3];
            const bf16x8 mfrag = __builtin_bit_cast(bf16x8, mfv);
#pragma unroll
            for (int pt = 0; pt < 4; ++pt) {
                v4u xv; xv.x = x0[pt].x; xv.y = x0[pt].y; xv.z = x1[pt].x; xv.w = x1[pt].y;
                yacc[pt] = mfma16(__builtin_bit_cast(bf16x8, xv), mfrag, yacc[pt]);
            }
        }
        const float ef = __builtin_amdgcn_exp2f(acs_l), eb = __builtin_amdgcn_exp2f(rb_l);
#pragma unroll
        for (int pt = 0; pt < 4; ++pt) {
            f32x4 df = (f32x4){0.f, 0.f, 0.f, 0.f}, db = (f32x4){0.f, 0.f, 0.f, 0.f};
#pragma unroll
            for (int kn = 0; kn < 4; ++kn) {
                const bf16x8 sfr = *(const LAS bf16x8*)(SF + (16 * pt + li) * BM_STRIDE + 32 * kn + 8 * g);
                const bf16x8 sbr = *(const LAS bf16x8*)(SB + (16 * pt + li) * BM_STRIDE + 32 * kn + 8 * g);
                df = mfma16(sfr, cf[kn], df); db = mfma16(sbr, cf[kn], db);
            }
            yacc[pt] = yacc[pt] + df * ef + db * eb;
        }
        const int t = t0 + l;
        float ssq = 0.f;
#pragma unroll
        for (int pt = 0; pt < 4; ++pt) {
            const int p = 16 * pt + 4 * g;
            const v2u xw = xwp[pt], zw = zwp[pt];
            float y0 = (yacc[pt][0] + Dskip * bflo(xw.x)) * silu_f(bflo(zw.x));
            float y1 = (yacc[pt][1] + Dskip * bfhi(xw.x)) * silu_f(bfhi(zw.x));
            float y2 = (yacc[pt][2] + Dskip * bflo(xw.y)) * silu_f(bflo(zw.y));
            float y3 = (yacc[pt][3] + Dskip * bfhi(xw.y)) * silu_f(bfhi(zw.y));
            ssq += (y0 * y0 + y1 * y1) + (y2 * y2 + y3 * y3);
            v2u o; o.x = pk2(y0, y1); o.y = pk2(y2, y3);
            *(v2u*)(YMIX + (size_t)t * DM + HYW + h * HDIM + p) = o;
        }
        ssq += __shfl_xor(ssq, 16); ssq += __shfl_xor(ssq, 32);
        if (g == 0) SSQ[(size_t)t * 32 + h] = ssq;
    }
}
__device__ __forceinline__ void mixer_norm_unit(int tb, const bf16* Z2T, const float* hog, const float* SSQ, const float* sog, bf16* YMIX, LAS unsigned char* lds, int tid) {
    LAS float* red = (LAS float*)lds;
    LAS float* rsh = (LAS float*)(lds + 16640);
    LAS float* rss = rsh + 64;
    LAS u16* tile = (LAS u16*)(lds + 20480);
    constexpr int TS = 264;
    const int t0 = 64 * tb, j = tid & 7, cc = tid >> 3;
    __syncthreads();
    float ps[8];
#pragma unroll
    for (int e = 0; e < 8; ++e) ps[e] = 0.f;
#pragma unroll 16
    for (int cbk = 0; cbk < 32; ++cbk) {
        const v4u v = *(const v4u*)(Z2T + (size_t)(64 * cbk + cc) * SEQ + t0 + 8 * j);
#pragma unroll
        for (int e = 0; e < 4; ++e) { const float a = bflo(v[e]), b = bfhi(v[e]); ps[2 * e] += a * a; ps[2 * e + 1] += b * b; }
    }
#pragma unroll
    for (int e = 0; e < 8; ++e) red[cc * 65 + 8 * j + e] = ps[e];
    __syncthreads();
    if (tid < 64) { float s = 0.f; for (int k = 0; k < 64; ++k) s += red[k * 65 + tid]; rsh[tid] = 1.0f / sqrtf(s * (1.f / HYW) + EPS); }
    { const int tk = tid >> 3, gq = tid & 7; const f32x4 q = *(const f32x4*)(SSQ + (size_t)(t0 + tk) * 32 + 4 * gq); rss[tk * 8 + gq] = 1.0f / sqrtf(((q.x + q.y) + (q.z + q.w)) * (1.f / 256.f) + EPS); }
    v4u cur[4], nxt[4];
#pragma unroll
    for (int i = 0; i < 4; ++i) cur[i] = *(const v4u*)(Z2T + (size_t)(cc + 64 * i) * SEQ + t0 + 8 * j);
#pragma unroll 1
    for (int cb4 = 0; cb4 < 8; ++cb4) {
        if (cb4 + 1 < 8) {
#pragma unroll
            for (int i = 0; i < 4; ++i) nxt[i] = *(const v4u*)(Z2T + (size_t)(256 * (cb4 + 1) + cc + 64 * i) * SEQ + t0 + 8 * j); }
#pragma unroll
        for (int i = 0; i < 4; ++i) { const bool odd = (cc & 1) != 0;
            const unsigned sx = odd ? cur[i].x : cur[i].z, sy = odd ? cur[i].y : cur[i].w;
            const unsigned rx = (unsigned)__builtin_amdgcn_update_dpp(0, (int)sx, 0x128, 0xF, 0xF, true), ry = (unsigned)__builtin_amdgcn_update_dpp(0, (int)sy, 0x128, 0xF, 0xF, true);
            const unsigned lx = odd ? rx : cur[i].x, ly = odd ? ry : cur[i].y, ux = odd ? cur[i].z : rx, uy = odd ? cur[i].w : ry;
            LAS u16* tp = tile + (8 * j + (odd ? 4 : 0)) * TS + (cc & ~1) + 64 * i;
            *(LAS unsigned*)(tp) = (lx & 0xffffu) | (ux << 16); *(LAS unsigned*)(tp + TS) = (lx >> 16) | (ux & 0xffff0000u);
            *(LAS unsigned*)(tp + 2 * TS) = (ly & 0xffffu) | (uy << 16); *(LAS unsigned*)(tp + 3 * TS) = (ly >> 16) | (uy & 0xffff0000u); }
        __syncthreads();
        { const int tk = tid >> 3; const float r = rsh[tk];
#pragma unroll
          for (int i = 0; i < 4; ++i) { const int c8 = (tid & 7) + 8 * i; const v4u w = *(const LAS v4u*)(tile + tk * TS + 8 * c8);
            const f32x4 g0 = *(const f32x4*)(hog + 256 * cb4 + 8 * c8), g1 = *(const f32x4*)(hog + 256 * cb4 + 8 * c8 + 4);
            v4u o; o.x = pk2(bflo(w.x) * r * g0.x, bfhi(w.x) * r * g0.y); o.y = pk2(bflo(w.y) * r * g0.z, bfhi(w.y) * r * g0.w);
            o.z = pk2(bflo(w.z) * r * g1.x, bfhi(w.z) * r * g1.y); o.w = pk2(bflo(w.w) * r * g1.z, bfhi(w.w) * r * g1.w);
            *(v4u*)(YMIX + (size_t)(t0 + tk) * DM + 256 * cb4 + 8 * c8) = o; } }
        __syncthreads();
#pragma unroll
        for (int i = 0; i < 4; ++i) cur[i] = nxt[i];
    }
    const int oc = tid & 255;
    const f32x4 g0 = *(const f32x4*)(sog + 8 * oc), g1 = *(const f32x4*)(sog + 8 * oc + 4);
#pragma unroll 16
    for (int i = 0; i < 32; ++i) { const int tk = (tid >> 8) + 2 * i;
        bf16* ptr = YMIX + (size_t)(t0 + tk) * DM + HYW + 8 * oc; const v4u w = *(const v4u*)ptr; const float r = rss[tk * 8 + (oc >> 5)];
        v4u o; o.x = pk2(bflo(w.x) * r * g0.x, bfhi(w.x) * r * g0.y); o.y = pk2(bflo(w.y) * r * g0.z, bfhi(w.y) * r * g0.w);
        o.z = pk2(bflo(w.z) * r * g1.x, bfhi(w.z) * r * g1.y); o.w = pk2(bflo(w.w) * r * g1.z, bfhi(w.w) * r * g1.w);
        *(v4u*)ptr = o; }
}

#ifndef MK_ONE_LAUNCH
#define MK_ONE_LAUNCH 1
#endif
constexpr int NPH = 12, PH_FINAL = 1 + DEPTH * NPH, PH_TOTAL = PH_FINAL + 1;
struct Args { const float* in[N_INPUTS]; float* out; unsigned char* ws; int ph_lo, ph_hi, use_bar, pad; };

__global__ void __launch_bounds__(512, 2) mk_fwd(Args a) {
    extern __shared__ __attribute__((aligned(16))) unsigned char lds_raw[];
    LAS unsigned char* lds = (LAS unsigned char*)lds_raw;
    const int G = gridDim.x, bid = blockIdx.x;
    const int wave_s = __builtin_amdgcn_readfirstlane((int)threadIdx.x >> 6);
    volatile LAS unsigned* MISC = (volatile LAS unsigned*)(lds + MISC_OFF);
    if (threadIdx.x < 64) MISC[threadIdx.x] = 0u;
    __syncthreads();
    unsigned* ctl = (unsigned*)(a.ws + WS_CTL);
    XcdBarrier bar; bar.bar = ctl + CW_BAR; bar.x = 0; bar.st = MISC + 8;
    if (a.use_bar) bar = xcd_barrier_post(ctl + CW_BAR, MISC + 8);
    const int lo = a.ph_lo, hi = a.ph_hi;
#ifndef MK_C1
#define MK_C1 1
#endif
#ifndef MK_C2
#define MK_C2 1
#endif
#ifndef MK_REP_MASK
#define MK_REP_MASK 0u
#endif
#define REPS(k) ((((unsigned)MK_REP_MASK >> (k)) & 1u) ? 2 : 1)
#define REP_LOOP(k) for (int rep_ = 0; rep_ < REPS(k); ++rep_)
#define REP_SEAM(k) do { if (rep_ + 1 < REPS(k)) xcd_barrier(bar); } while (0)
#ifndef MK_TAPS
#define MK_TAPS 1
#endif
#ifndef MK_PHMASK
#define MK_PHMASK 0xFFFFu
#endif
#define IN(p) (lo <= (p) && (p) < hi)
#define INL(k) (((MK_PHMASK >> (k)) & 1u) && IN(pb + (k)))
#ifndef MK_DBL_BAR
#define MK_DBL_BAR 0
#endif
#define SEAM(p) do { if (IN(p) && IN((p) + 1)) { xcd_barrier(bar); if (MK_DBL_BAR) xcd_barrier(bar); } } while (0)
#define CAS __attribute__((address_space(4)))
#define PHASE_BEGIN \
    const char CAS* kp = (const char CAS*)__builtin_amdgcn_kernarg_segment_ptr(); asm volatile("" : "+s"(kp)); \
    unsigned char* ws = *(unsigned char* const CAS*)(kp + 8 * (N_INPUTS + 1)); \
    unsigned z_ = 0u; asm volatile("" : "+v"(z_)); int wv_ = wave_s; asm volatile("" : "+s"(wv_)); \
    const int tid = wv_ * 64 + (int)__builtin_amdgcn_mbcnt_hi(~0u, __builtin_amdgcn_mbcnt_lo(~0u, z_)); \
    const int lane = tid & 63, wave = wave_s; \
    const int vcu = (G % 8 == 0) ? (bid % 8) * (G / 8) + bid / 8 : bid; \
    const int gw = vcu * 8 + wave, NGW = G * 8; (void)lane; (void)gw; (void)NGW; (void)ws
#ifndef MK_STAG_US
#define MK_STAG_US 0
#endif
#define STAGGER() do { if (MK_STAG_US) { const unsigned long long t0_ = __builtin_amdgcn_s_memrealtime(); const unsigned long long d_ = (unsigned long long)(((bid >> 3) & 7) * MK_STAG_US * 100); while (__builtin_amdgcn_s_memrealtime() - t0_ < d_) __builtin_amdgcn_s_sleep(8); } } while (0)
#define INP(i) (*(const float* const CAS*)(kp + 8 * (i)))
#define OUTP() (*(float* const CAS*)(kp + 8 * N_INPUTS))
#define WSP(T, off) ((T*)(ws + (off)))

    if (IN(0)) {
        PHASE_BEGIN;
        f32x2* TW = WSP(f32x2, WS_TW); f32x2* PW = WSP(f32x2, WS_PW);
        for (int i = bid * 512 + tid; i < 16384 + 8193; i += G * 512) {
            float s, c;
            if (i < 16384) { sincospif((float)i / 8192.0f, &s, &c); TW[i] = (f32x2){c, -s}; }
            else { const int k = i - 16384; sincospif((float)k / 16384.0f, &s, &c); PW[k] = (f32x2){c, -s}; }
        }
    }

#pragma unroll 1
    for (int l = 0; l < DEPTH; ++l) {
        const int pb = 1 + l * NPH;
        if (INL(0)) REP_LOOP(0) {
            PHASE_BEGIN;
            LAS float* scr = (LAS float*)(lds + wave * 16384);
            const float* win = INP(I_WIN) + (size_t)l * DM * NIN; const float* wo = INP(I_WO) + (size_t)l * DM * DM;
            bf16* WIN = WSP(bf16, WS_WIN); bf16* WOUT = WSP(bf16, WS_WOUT);
            const float* gmix = INP(I_NMG) + (size_t)l * DM;
            constexpr int IT_IN = (DM / 64) * (NIN / 32), IT_O = (DM / 64) * (DM / 32);
            for (int it = gw; it < IT_IN + IT_O; it += NGW) {
                int r = it;
                if (r < IT_IN) { transpose_item(win, DM, NIN, WIN, scr, r, lane, gmix); continue; } r -= IT_IN;
                transpose_item(wo, DM, DM, WOUT, scr, r, lane, nullptr);
            }
            if (l == 0) { const float* xin = INP(I_X); bf16* XB = WSP(bf16, WS_XN); float* sa = WSP(float, WS_SSQA);
                for (int m = gw; m < SEQ; m += NGW) prep_row(xin + (size_t)m * DM, XB + (size_t)m * DM, sa + m, lane); }
            else { const int i = bid * 512 + tid; if (i < SEQ) rstd_reduce(WSP(const float, WS_PARTA), WSP(float, WS_SSQA), i);
                   if (bid == 0) for (int i2 = G * 512 + tid; i2 < SEQ; i2 += 512) rstd_reduce(WSP(const float, WS_PARTA), WSP(float, WS_SSQA), i2); }
            const float* w1 = INP(I_PW1) + (size_t)l * 33 * 64; const float* b1 = INP(I_PB1) + (size_t)l * 64;
            const float* w2 = INP(I_PW2) + (size_t)l * 64 * 64; const float* b2 = INP(I_PB2) + (size_t)l * 64;
            const float* w3 = INP(I_PW3) + (size_t)l * 64 * 64; const float* b3 = INP(I_PB3) + (size_t)l * 64;
            const float* sf = INP(I_SF) + (size_t)l * 3 * 64; bf16* H3 = WSP(bf16, WS_H3);
            for (int t = gw; t < SEQ; t += 8 * NGW) posmlp_rows8(t, NGW, w1, b1, w2, b2, w3, b3, sf, H3, lane);
            REP_SEAM(0);
        }
        SEAM(pb + 0);
        const bool early_ = ((bid >> 3) & 1) == 0;
#pragma unroll 1
        for (int step_ = 0; step_ < 2; ++step_) {
          if ((step_ == 0) == early_) {
            if (INL(2)) REP_LOOP(12) {
                PHASE_BEGIN;
                if (rep_) xcd_barrier(bar);
                LAS float* scr = (LAS float*)(lds + wave * 16384);
                const float* wup = INP(I_WUP) + (size_t)l * DM * DFF; const float* wdn = INP(I_WDN) + (size_t)l * DFF * DM;
                bf16* WUP = WSP(bf16, WS_WUP); bf16* WDN = WSP(bf16, WS_WDN);
                const float* gmlp = INP(I_NLG) + (size_t)l * DM;
                constexpr int IT_UP = (DM / 64) * (DFF / 32), IT_DN = (DFF / 64) * (DM / 32);
                __syncthreads();
                for (int it = gw; it < IT_UP + IT_DN; it += NGW) {
                    if (it < IT_UP) transpose_item(wup, DM, DFF, WUP, scr, it, lane, gmlp);
                    else transpose_item(wdn, DFF, DM, WDN, scr, it - IT_UP, lane, nullptr);
                }
                if (MK_TAPS) taps_gemm(INP(I_WOUTF) + (size_t)l * 64 * NTAP, WSP(bf16, WS_H3), WSP(bf16, WS_HT), gw, NGW, lane);
                __syncthreads();
            }
          } else {
            if (INL(1)) REP_LOOP(1) {
                PHASE_BEGIN;
                pg8::Gemm g{WSP(bf16, WS_WIN), WSP(bf16, WS_XN), 3 * HYW, SEQ, DM}; pg8::StaticOrder S; S.init(3 * HYW, SEQ, G, bid);
                pg8::EpiBf16P<0, 2> E{WSP(bf16, WS_PT), SEQ, WSP(const float, WS_SSQA)};
                pg8::gemm_phase<pg8::EpiBf16P<0, 2>, pg8::StaticOrder, true, true>(lds, g, S, E, tid);
                REP_SEAM(1);
            }
            if (INL(2)) REP_LOOP(2) {
                PHASE_BEGIN;
                if (rep_) xcd_barrier(bar);
                pg8::Gemm g{WSP(bf16, WS_XN), WSP(bf16, WS_WIN) + (size_t)3 * HYW * DM, SEQ, PSW, DM}; pg8::StaticOrder S; S.init(SEQ, PSW, G, bid);
                pg8::EpiBf16P<0, 1> E{WSP(bf16, WS_PS), PSW, WSP(const float, WS_SSQA)};
                pg8::gemm_phase<pg8::EpiBf16P<0, 1>, pg8::StaticOrder, true, true>(lds, g, S, E, tid);
            }
          }
        }
        SEAM(pb + 2);
        const bool ssm_first_ = ((bid >> 3) & 1) == 0;
#pragma unroll 1
        for (int step_ = 0; step_ < 2; ++step_) {
        if ((step_ == 0) == ssm_first_) {
        if (MK_C1 && INL(3)) REP_LOOP(13) {
            PHASE_BEGIN;
            if (rep_) xcd_barrier(bar);
            LAS unsigned* wctr = (LAS unsigned*)(lds + MISC_OFF + 64);
            __syncthreads(); if (tid == 0) *wctr = 0u; __syncthreads();
            if (wave < 4) for (int tile = vcu * 4 + wave; tile < SEQ / 16; tile += G * 4) ssm_dt_tile(tile, WSP(bf16, WS_XN), WSP(bf16, WS_WIN) + (size_t)(3 * HYW + PSW) * DM, WSP(const float, WS_SSQA), WSP(float, WS_DTRAW), lane);
            { const float* cw = INP(I_SCW) + (size_t)l * 3 * XBCW; const float* cb = INP(I_SCB) + (size_t)l * XBCW;
              for (;;) { unsigned k = 0u; if (lane == 0) k = __hip_atomic_fetch_add(wctr, 1u, __ATOMIC_RELAXED, __HIP_MEMORY_SCOPE_WORKGROUP);
                  k = (unsigned)__builtin_amdgcn_readfirstlane((int)k);
                  const unsigned idx = (unsigned)bid + k * (unsigned)G;
                  if (idx >= 512u * 512u / 64u) break;
                  ssm_conv_item(WSP(bf16, WS_PS), cw, cb, WSP(bf16, WS_XBC), (int)(idx * 64u) + lane); } }
            __syncthreads();
        }
        } else {
        if (MK_C2 && INL(3)) REP_LOOP(3) {
            PHASE_BEGIN;
            if (rep_) xcd_barrier(bar);
            const float* cw = INP(I_HCW) + (size_t)l * 3 * 3 * HYW; const float* cb = INP(I_HCB) + (size_t)l * 3 * HYW; const float* sk = INP(I_SKIP) + (size_t)l * 2 * HYW;
            __syncthreads(); fft_fill_twl(WSP(f32x2, WS_TW), WSP(f32x2, WS_PW), lds, tid); __syncthreads();
            for (int c = bid; c < HYW; c += G) hyena_channel(c, WSP(bf16, WS_PT), WSP(bf16, WS_HT), cw, cb, sk, WSP(bf16, WS_Z2T), (f32x4*)(ws + WS_GSCR + (size_t)bid * GSCR_PER_WG), lds, tid);
        }
        } }
        SEAM(pb + 3);
        if (INL(4)) REP_LOOP(4) { PHASE_BEGIN; if (rep_) xcd_barrier(bar);
            for (int pr = vcu; pr < NCH * (NHEAD / 4); pr += G)
#pragma unroll 1
                for (int hh = 0; hh < 4; ++hh) { int c_ = pr >> 3, h_ = 4 * (pr & 7) + hh; asm volatile("" : "+s"(c_), "+s"(h_));
                    ssd_states_unit(c_, h_, WSP(bf16, WS_XBC), WSP(float, WS_DTRAW), INP(I_ALOG) + (size_t)l * 64, INP(I_DTB) + (size_t)l * 64,
                                                                       WSP(float, WS_DTF), WSP(float, WS_DTB), WSP(float, WS_ACS), WSP(float, WS_RB), WSP(bf16, WS_S), lds, tid, hh == 0); } }
        SEAM(pb + 4);
        if (INL(5)) REP_LOOP(5) { PHASE_BEGIN; if (rep_) xcd_barrier(bar);
            for (int e4 = bid * 512 + tid; e4 < 2 * NHEAD * HDIM * NST / 4; e4 += G * 512) ssd_scan_item(e4, WSP(bf16, WS_S), WSP(float, WS_ACS), WSP(float, WS_RB), WSP(bf16, WS_SIN)); }
        SEAM(pb + 5);
        if (INL(6)) REP_LOOP(6) { PHASE_BEGIN; if (rep_) xcd_barrier(bar); const float* sd = INP(I_SD) + (size_t)l * NHEAD;
            for (int pr = vcu; pr < NCH * (NHEAD / 4); pr += G)
#pragma unroll 1
                for (int hh = 0; hh < 4; ++hh) { int c_ = pr >> 3, h_ = 4 * (pr & 7) + hh; asm volatile("" : "+s"(c_), "+s"(h_));
                    ssd_out_unit(c_, h_, WSP(bf16, WS_XBC), WSP(bf16, WS_PS), WSP(float, WS_DTF), WSP(float, WS_DTB), WSP(float, WS_ACS), WSP(float, WS_RB),
                                                                    WSP(bf16, WS_SIN), sd[h_], WSP(bf16, WS_YMIX), WSP(float, WS_SSQ), lds, tid, hh == 0); } }
        SEAM(pb + 6);
        if (INL(7)) { PHASE_BEGIN;
            for (int tb = bid; tb < SEQ / 64; tb += G) mixer_norm_unit(tb, WSP(bf16, WS_Z2T), INP(I_HOG) + (size_t)l * HYW, WSP(float, WS_SSQ), INP(I_SOG) + (size_t)l * SSW, WSP(bf16, WS_YMIX), lds, tid); }
        SEAM(pb + 7);
        if (INL(8)) REP_LOOP(8) { PHASE_BEGIN; if (rep_) xcd_barrier(bar);
            STAGGER();
            pg8::Gemm g{WSP(bf16, WS_YMIX), WSP(bf16, WS_WOUT), SEQ, DM, DM}; pg8::StaticOrder S; S.init(SEQ, DM, G, bid);
            pg8::EpiRes E{WSP(bf16, WS_XN), WSP(float, WS_X), WSP(float, WS_PARTB), DM, SEQ, 0};
            pg8::gemm_phase<pg8::EpiRes, pg8::StaticOrder, true, true>(lds, g, S, E, tid); }
        SEAM(pb + 8);
        if (INL(10)) REP_LOOP(10) { PHASE_BEGIN; if (rep_) xcd_barrier(bar);
            pg8::Gemm g{WSP(bf16, WS_XN), WSP(bf16, WS_WUP), SEQ, DFF, DM}; pg8::StaticOrder S; S.init(SEQ, DFF, G, bid);
            { pg8::Unit u0; int last = -1;
#pragma unroll 1
              for (int i = 0; S.next(i, u0); ++i) if (u0.pm != last) { last = u0.pm; if (tid < 256) rstd_reduce(WSP(const float, WS_PARTB), WSP(float, WS_SSQB), u0.pm * 256 + tid); }
              __syncthreads(); }
            pg8::EpiBf16P<1, 1> E{WSP(bf16, WS_H), DFF, WSP(const float, WS_SSQB)};
            pg8::gemm_phase<pg8::EpiBf16P<1, 1>, pg8::StaticOrder, true, true>(lds, g, S, E, tid); }
        SEAM(pb + 10);
        if (INL(11)) REP_LOOP(11) { PHASE_BEGIN; if (rep_) xcd_barrier(bar);
            STAGGER();
            pg8::Gemm g{WSP(bf16, WS_H), WSP(bf16, WS_WDN), SEQ, DM, DFF}; pg8::StaticOrder S; S.init(SEQ, DM, G, bid);
            pg8::EpiRes E{WSP(bf16, WS_XN), WSP(float, WS_X), WSP(float, WS_PARTA), DM, SEQ, 0};
            pg8::gemm_phase<pg8::EpiRes, pg8::StaticOrder, true, true>(lds, g, S, E, tid); }
        SEAM(pb + 11);
    }
    if (IN(PH_FINAL)) { PHASE_BEGIN; const bf16* X = WSP(const bf16, WS_XN); float* out = OUTP();
        for (int m = gw; m < SEQ; m += NGW) rms_row_b(X + (size_t)m * DM, INP(I_FNG), out + (size_t)m * DM, lane); }
#undef IN
#undef INL
#undef SEAM
}

extern "C" void kernel_launch(void* const* d_in, const int* in_sizes, int n_in, void* d_out, int out_size, void* d_ws, size_t ws_size, hipStream_t stream) {
    static int grid = 0;
    if (grid == 0) {
        if (n_in != N_INPUTS || in_sizes[0] != SEQ * DM || out_size != SEQ * DM || ws_size < WS_END) {
            fprintf(stderr, "kernel_launch: unexpected problem: n_in %d in0 %d out %d ws %zu (need %zu)\n", n_in, n_in > 0 ? in_sizes[0] : -1, out_size, ws_size, (size_t)WS_END); grid = -1; return; }
        int dev = 0, cus = 0;
        if (hipGetDevice(&dev) != hipSuccess || hipDeviceGetAttribute(&cus, hipDeviceAttributeMultiprocessorCount, dev) != hipSuccess) { grid = -1; return; }
        if (hipFuncSetAttribute((const void*)mk_fwd, hipFuncAttributeMaxDynamicSharedMemorySize, LDS_BYTES) != hipSuccess) { fprintf(stderr, "kernel_launch: hipFuncSetAttribute failed\n"); grid = -1; return; }
        int per_cu = 0;
        if (hipOccupancyMaxActiveBlocksPerMultiprocessor(&per_cu, (const void*)mk_fwd, 512, LDS_BYTES) != hipSuccess || per_cu < 1) fprintf(stderr, "kernel_launch: occupancy query reports %d\n", per_cu);
        (void)hipGetLastError();
        grid = cus;
    }
    if (grid < 0) return;
    if (hipMemsetAsync((char*)d_ws + WS_CTL, 0, CTL_ZERO_BYTES, stream) != hipSuccess) return;
    Args a{};
    for (int i = 0; i < N_INPUTS; ++i) a.in[i] = (const float*)d_in[i];
    a.out = (float*)d_out; a.ws = (unsigned char*)d_ws; a.pad = 0;
#if MK_ONE_LAUNCH
    a.ph_lo = 0; a.ph_hi = PH_TOTAL; a.use_bar = 1;
    hipLaunchKernelGGL(mk_fwd, dim3(grid), dim3(512), LDS_BYTES, stream, a);
#else
    for (int p = 0; p < PH_TOTAL; ++p) { a.ph_lo = p; a.ph_hi = p + 1; a.use_bar = 0;
        hipLaunchKernelGGL(mk_fwd, dim3(grid), dim3(512), LDS_BYTES, stream, a); }
#endif
}
```

```cpp
#include <hip/hip_runtime.h>
#include <cstdio>
#include <cstdint>
namespace pg8 {
#define PG8_LAS __attribute__((address_space(3)))
typedef unsigned short bf16_t;
typedef short bf16x8 __attribute__((ext_vector_type(8)));
typedef float f32x4 __attribute__((ext_vector_type(4)));
typedef unsigned u32x4 __attribute__((ext_vector_type(4)));
constexpr int BM = 256, BK = 64, HALF = 128, HTB = HALF * BK * 2  , STAGE_BYTES = 8 * HTB, NXCD = 8, WGM = 8;

__host__ __device__ __forceinline__ int lds_byte(int r, int c) { const int st = (r >> 4) * 2 + (c >> 5), rr = r & 15, cc = c & 31, ob = rr * 64 + cc * 2; return st * 1024 + (ob ^ (((ob >> 9) & 1) << 5)); }
__host__ __device__ __forceinline__ void stage_rc(int b, int& R, int& C) { const int st = b / 1024, sb = b % 1024, swz = sb ^ (((sb >> 9) & 1) << 5); R = (st >> 1) * 16 + swz / 64; C = (st & 1) * 32 + (swz % 64) / 2; }
__host__ __device__ __forceinline__ int perm32(int rho) { const int n = rho >> 4, i = rho & 15; return 8 * (i >> 2) + 4 * n + (i & 3); }

struct Unit { int pm, pn; };
struct Gemm { const bf16_t* A; const bf16_t* Bt; int M, N, K; };

struct StaticOrder {
    int nM, nN, nwg, G, c;
    __host__ __device__ void init(int M, int N, int G_, int c_) { nM = M / BM; nN = N / BM; nwg = nM * nN; G = G_; c = c_; }
    __host__ __device__ bool next(int i, Unit& u) const {
        const long L = (long)i * G + c; if (L >= nwg) return false;
        int wgid = (int)L; { const int q = nwg / NXCD, r = nwg % NXCD, xcd = wgid % NXCD, off = wgid / NXCD; wgid = (xcd < r ? xcd * (q + 1) : r * (q + 1) + (xcd - r) * q) + off; }
        const int nig = WGM * nN, gid = wgid / nig, fm = gid * WGM, gsz = (nM - fm) < WGM ? (nM - fm) : WGM;
        u.pm = fm + ((wgid % nig) % gsz); u.pn = (wgid % nig) / gsz; return true;
    }
    __device__ __forceinline__ void a_ready(const Unit&) const {}
    __device__ __forceinline__ void done(const Unit&) const {}
};

__device__ __forceinline__ unsigned cvt_pk_bf16(float lo, float hi) { unsigned r; asm volatile("v_cvt_pk_bf16_f32 %0, %1, %2" : "=v"(r) : "v"(lo), "v"(hi)); return r; }
__device__ __forceinline__ float rstd_of(float ssq) { return 1.0f / sqrtf(ssq * (1.0f / 4096.0f) + 1e-5f); }
template <int ACT, int MODE> struct EpiBf16P {
    static constexpr bool PERM = true, AFTER_DRAIN = false;
    bf16_t* O; int ldc; const float* rstd;
    __device__ __forceinline__ void operator()(const f32x4 (&acc)[2][2][4][2], const Unit& u, int wr, int wc, int fr, int fq) const {
        const int row0 = u.pm * BM + wr * 64 + fr, col0 = u.pn * BM + wc * 32 + 8 * fq;
        f32x4 cs[2][2];
        if (MODE == 2) {
#pragma unroll
            for (int bj = 0; bj < 2; ++bj)
#pragma unroll
                for (int n = 0; n < 2; ++n) cs[bj][n] = *(const f32x4*)(rstd + col0 + bj * HALF + 4 * n);
        }
#pragma unroll
        for (int ai = 0; ai < 2; ++ai)
#pragma unroll
            for (int m = 0; m < 4; ++m) { const int row = row0 + ai * HALF + m * 16; bf16_t* rowp = O + (size_t)row * ldc + col0;
                float rs = 1.f; if (MODE == 1) rs = rstd[row];
#pragma unroll
                for (int bj = 0; bj < 2; ++bj) { f32x4 v0 = acc[ai][bj][m][0], v1 = acc[ai][bj][m][1];
                    if (MODE == 1) { v0 = v0 * rs; v1 = v1 * rs; }
                    if (MODE == 2) { v0 = v0 * cs[bj][0]; v1 = v1 * cs[bj][1]; }
                    if (ACT == 1) {
#pragma unroll
                        for (int j = 0; j < 4; ++j) { const float a = fmaxf(v0[j], 0.f), b = fmaxf(v1[j], 0.f); v0[j] = a * a; v1[j] = b * b; } }
                    u32x4 w; w.x = cvt_pk_bf16(v0[0], v0[1]); w.y = cvt_pk_bf16(v0[2], v0[3]); w.z = cvt_pk_bf16(v1[0], v1[1]); w.w = cvt_pk_bf16(v1[2], v1[3]);
                    *(u32x4*)(rowp + bj * HALF) = w; } }
    }
};
struct EpiRes {
    static constexpr bool PERM = true, AFTER_DRAIN = false;
    bf16_t* xb; float* out32; float* part; int ldc, nrows, last;
    __device__ __forceinline__ void operator()(const f32x4 (&acc)[2][2][4][2], const Unit& u, int wr, int wc, int fr, int fq) const {
        const int row0 = u.pm * BM + wr * 64 + fr, col0 = u.pn * BM + wc * 32 + 8 * fq;
#pragma unroll
        for (int ai = 0; ai < 2; ++ai) {
            u32x4 bs[4][2];
#pragma unroll
            for (int m = 0; m < 4; ++m) { const size_t off = (size_t)(row0 + ai * HALF + m * 16) * ldc + col0;
#pragma unroll
                for (int bj = 0; bj < 2; ++bj) bs[m][bj] = *(const u32x4*)(xb + off + bj * HALF); }
            asm volatile("" ::: "memory");
#pragma unroll
            for (int m = 0; m < 4; ++m) { const int row = row0 + ai * HALF + m * 16; const size_t off = (size_t)row * ldc + col0;
                float sq = 0.f;
#pragma unroll
                for (int bj = 0; bj < 2; ++bj) { const u32x4 b = bs[m][bj];
                    f32x4 r0, r1;
                    r0[0] = __uint_as_float(b.x << 16); r0[1] = __uint_as_float(b.x & 0xffff0000u); r0[2] = __uint_as_float(b.y << 16); r0[3] = __uint_as_float(b.y & 0xffff0000u);
                    r1[0] = __uint_as_float(b.z << 16); r1[1] = __uint_as_float(b.z & 0xffff0000u); r1[2] = __uint_as_float(b.w << 16); r1[3] = __uint_as_float(b.w & 0xffff0000u);
                    const f32x4 o0 = r0 + acc[ai][bj][m][0], o1 = r1 + acc[ai][bj][m][1];
                    { u32x4 w; w.x = cvt_pk_bf16(o0[0], o0[1]); w.y = cvt_pk_bf16(o0[2], o0[3]); w.z = cvt_pk_bf16(o1[0], o1[1]); w.w = cvt_pk_bf16(o1[2], o1[3]);
                           *(u32x4*)(xb + off + bj * HALF) = w; }
                    sq += ((o0[0] * o0[0] + o0[1] * o0[1]) + (o0[2] * o0[2] + o0[3] * o0[3])) + ((o1[0] * o1[0] + o1[1] * o1[1]) + (o1[2] * o1[2] + o1[3] * o1[3])); }
                sq += __shfl_xor(sq, 16); sq += __shfl_xor(sq, 32);
                if (fq == 0) part[(size_t)(4 * u.pn + wc) * nrows + row] = sq; }
            asm volatile("" ::: "memory");
        }
    }
};

template <class Epi, class Sched, bool ALIGN_EPI = false, bool SP2 = false>
__device__ __forceinline__ void gemm_phase(PG8_LAS unsigned char* lds, const Gemm g, const Sched& S, const Epi& E, int tid_arg) {
    int tid_ = tid_arg; asm volatile("" : "+v"(tid_));
    const int tid = tid_, wid = __builtin_amdgcn_readfirstlane(tid >> 6), lane = tid & 63, wr = wid >> 2, wc = wid & 3, fr = lane & 15, fq = lane >> 4;
    const int K = g.K, nt = K / BK;
    unsigned voffA[2], voffB[2];
#pragma unroll
    for (int i = 0; i < 2; ++i) { int R, C; stage_rc(tid * 16 + i * 8192, R, C); const int Rb = Epi::PERM ? ((R & ~31) + perm32(R & 31)) : R;
        voffA[i] = (unsigned)(R * K + C) * 2u; voffB[i] = (unsigned)(Rb * K + C) * 2u; }
    const size_t kstep = (size_t)(BK * 2);
    const size_t hstep = (size_t)HALF * K * 2;
    const size_t tstep = 2 * hstep;
    const unsigned ldsw = (unsigned)wid * 1024u;
    const int aoff = lds_byte(wr * 64 + fr, fq * 8), boff = lds_byte(wc * 32 + fr, fq * 8);
#define PG8_SA(b, h) (((b) * 2 + (h)) * HTB)
#define PG8_SB(b, h) ((4 + (b) * 2 + (h)) * HTB)
#define PG8_STAGE(bufoff, gbase, voff) do { _Pragma("unroll") for (int _i = 0; _i < 2; ++_i) \
        __builtin_amdgcn_global_load_lds((const unsigned*)((const char*)(gbase) + (voff)[_i]), (PG8_LAS unsigned*)(lds + (bufoff) + ldsw + _i * 8192), 16, 0, 0); } while (0)
#define PG8_LDA(dst, b, h) do { _Pragma("unroll") for (int m = 0; m < 4; ++m) _Pragma("unroll") for (int k = 0; k < 2; ++k) dst[m][k] = *(const PG8_LAS bf16x8*)(lds + PG8_SA(b, h) + aoff + m * 2048 + k * 1024); } while (0)
#define PG8_LDB(dst, b, h) do { _Pragma("unroll") for (int n = 0; n < 2; ++n) _Pragma("unroll") for (int k = 0; k < 2; ++k) dst[n][k] = *(const PG8_LAS bf16x8*)(lds + PG8_SB(b, h) + boff + n * 2048 + k * 1024); } while (0)
#define PG8_MMA(ai, bj, At, Bt) do { __builtin_amdgcn_s_setprio(1); _Pragma("unroll") for (int m = 0; m < 4; ++m) _Pragma("unroll") for (int n = 0; n < 2; ++n) _Pragma("unroll") for (int k = 0; k < 2; ++k) \
        acc[ai][bj][m][n] = __builtin_amdgcn_mfma_f32_16x16x32_bf16(Bt[n][k], At[m][k], acc[ai][bj][m][n], 0, 0, 0); __builtin_amdgcn_s_setprio(0); } while (0)
#define PG8_WAIT_V(n) asm volatile("s_waitcnt vmcnt(" #n ")" ::: "memory")
#define PG8_WAIT_L(n) asm volatile("s_waitcnt lgkmcnt(" #n ")" ::: "memory")
#define PG8_BAR __builtin_amdgcn_s_barrier()
#define PG8_SCHED __builtin_amdgcn_sched_barrier(0)
    Unit cur, nxt; int ui = 0;
    if (!S.next(0, cur)) return;
    f32x4 acc[2][2][4][2];
#pragma unroll
    for (int a = 0; a < 2; ++a)
#pragma unroll
        for (int b = 0; b < 2; ++b)
#pragma unroll
            for (int m = 0; m < 4; ++m)
#pragma unroll
                for (int n = 0; n < 2; ++n) acc[a][b][m][n] = (f32x4){0.f, 0.f, 0.f, 0.f};
    bf16x8 At[4][2], B0[2][2], B1[2][2];
    const char* cA = (const char*)g.A + (size_t)cur.pm * tstep; const char* cB = (const char*)g.Bt + (size_t)cur.pn * tstep;
    S.a_ready(cur);
    if constexpr (SP2) {
        PG8_STAGE(PG8_SB(0, 0), cB, voffB); PG8_STAGE(PG8_SB(0, 1), cB + hstep, voffB); PG8_STAGE(PG8_SA(0, 0), cA, voffA); PG8_STAGE(PG8_SA(0, 1), cA + hstep, voffA);
        if (wr == 1) PG8_BAR;
        PG8_WAIT_V(2); PG8_BAR;
        PG8_STAGE(PG8_SB(1, 0), cB + kstep, voffB); PG8_STAGE(PG8_SA(1, 0), cA + kstep, voffA); PG8_STAGE(PG8_SB(1, 1), cB + hstep + kstep, voffB);
        PG8_WAIT_V(6); PG8_BAR;
    } else {
        PG8_STAGE(PG8_SB(0, 0), cB, voffB); PG8_STAGE(PG8_SA(0, 0), cA, voffA); PG8_STAGE(PG8_SB(0, 1), cB + hstep, voffB); PG8_STAGE(PG8_SA(0, 1), cA + hstep, voffA);
        if (wr == 1) PG8_BAR;
        PG8_WAIT_V(4); PG8_BAR;
        PG8_STAGE(PG8_SB(1, 0), cB + kstep, voffB); PG8_STAGE(PG8_SA(1, 0), cA + kstep, voffA); PG8_STAGE(PG8_SB(1, 1), cB + hstep + kstep, voffB);
        PG8_WAIT_V(6); PG8_BAR;
    }
    for (;;) {
        const bool has_next = S.next(ui + 1, nxt);
        const char* nA = has_next ? (const char*)g.A + (size_t)nxt.pm * tstep : cA; const char* nB = has_next ? (const char*)g.Bt + (size_t)nxt.pn * tstep : cB;
        for (int t = 0; t < nt; t += 2) {
            const bool last = (t == nt - 2);
            const char* a1 = cA + (size_t)(t + 1) * kstep;
            const char* a2 = last ? nA : cA + (size_t)(t + 2) * kstep; const char* b2 = last ? nB : cB + (size_t)(t + 2) * kstep;
            const char* a3 = a2 + kstep; const char* b3 = b2 + kstep;
            if (last && has_next) S.a_ready(nxt);
            if constexpr (SP2) {
            PG8_LDB(B0, 0, 0); PG8_LDB(B1, 0, 1); PG8_SCHED; PG8_LDA(At, 0, 0); PG8_STAGE(PG8_SA(1, 1), a1 + hstep, voffA);
            PG8_WAIT_V(8); PG8_WAIT_L(0); PG8_BAR; PG8_MMA(0, 0, At, B0); PG8_MMA(0, 1, At, B1); PG8_BAR; PG8_SCHED;
            PG8_LDA(At, 0, 1); PG8_STAGE(PG8_SB(0, 0), b2, voffB); PG8_STAGE(PG8_SB(0, 1), b2 + hstep, voffB); PG8_STAGE(PG8_SA(0, 0), a2, voffA);
            PG8_WAIT_V(8); PG8_WAIT_L(0); PG8_BAR; PG8_MMA(1, 0, At, B0); PG8_MMA(1, 1, At, B1); PG8_BAR; PG8_SCHED;
            PG8_LDB(B0, 1, 0); PG8_LDB(B1, 1, 1); PG8_SCHED; PG8_LDA(At, 1, 0); PG8_STAGE(PG8_SA(0, 1), a2 + hstep, voffA);
            PG8_WAIT_V(8); PG8_WAIT_L(0); PG8_BAR; PG8_MMA(0, 0, At, B0); PG8_MMA(0, 1, At, B1); PG8_BAR; PG8_SCHED;
            PG8_LDA(At, 1, 1); PG8_STAGE(PG8_SB(1, 0), b3, voffB); PG8_STAGE(PG8_SB(1, 1), b3 + hstep, voffB); PG8_STAGE(PG8_SA(1, 0), a3, voffA);
            PG8_WAIT_V(8); PG8_WAIT_L(0); PG8_BAR; PG8_MMA(1, 0, At, B0); PG8_MMA(1, 1, At, B1); PG8_BAR; PG8_SCHED;
            } else {
            PG8_LDB(B0, 0, 0); PG8_SCHED; PG8_LDA(At, 0, 0); PG8_STAGE(PG8_SA(1, 1), a1 + hstep, voffA);
            PG8_WAIT_L(8); PG8_BAR; PG8_WAIT_L(0); PG8_MMA(0, 0, At, B0); PG8_BAR; PG8_SCHED;
            PG8_LDB(B1, 0, 1); PG8_STAGE(PG8_SB(0, 0), b2, voffB);
            PG8_BAR; PG8_WAIT_L(0); PG8_MMA(0, 1, At, B1); PG8_BAR;
            PG8_LDA(At, 0, 1); PG8_STAGE(PG8_SA(0, 0), a2, voffA);
            PG8_BAR; PG8_WAIT_L(0); PG8_MMA(1, 0, At, B0); PG8_BAR; PG8_SCHED;
            PG8_STAGE(PG8_SB(0, 1), b2 + hstep, voffB);
            PG8_WAIT_V(6); PG8_BAR; PG8_MMA(1, 1, At, B1); PG8_BAR;
            PG8_LDB(B0, 1, 0); PG8_SCHED; PG8_LDA(At, 1, 0); PG8_STAGE(PG8_SA(0, 1), a2 + hstep, voffA);
            PG8_WAIT_L(8); PG8_BAR; PG8_WAIT_L(0); PG8_MMA(0, 0, At, B0); PG8_BAR; PG8_SCHED;
            PG8_LDB(B1, 1, 1); PG8_STAGE(PG8_SB(1, 0), b3, voffB);
            PG8_BAR; PG8_WAIT_L(0); PG8_MMA(0, 1, At, B1); PG8_BAR;
            PG8_LDA(At, 1, 1); PG8_STAGE(PG8_SA(1, 0), a3, voffA);
            PG8_BAR; PG8_WAIT_L(0); PG8_MMA(1, 0, At, B0); PG8_BAR; PG8_SCHED;
            PG8_STAGE(PG8_SB(1, 1), b3 + hstep, voffB);
            PG8_WAIT_V(6); PG8_BAR; PG8_MMA(1, 1, At, B1); PG8_BAR;
            }
        }
        if constexpr (ALIGN_EPI) { if (wr == 0) PG8_BAR; }
        if constexpr (!Epi::AFTER_DRAIN) { E(acc, cur, wr, wc, fr, fq); S.done(cur); }
        if (!has_next) break;
#pragma unroll
        for (int a = 0; a < 2; ++a)
#pragma unroll
            for (int b = 0; b < 2; ++b)
#pragma unroll
                for (int m = 0; m < 4; ++m)
#pragma unroll
                    for (int n = 0; n < 2; ++n) acc[a][b][m][n] = (f32x4){0.f, 0.f, 0.f, 0.f};
        cur = nxt; cA = nA; cB = nB; ++ui;
        if constexpr (ALIGN_EPI) { if (wr == 1) PG8_BAR; }
    }
    PG8_WAIT_V(0);
    if constexpr (!ALIGN_EPI) { if (wr == 0) PG8_BAR; }
    PG8_BAR;
    if constexpr (Epi::AFTER_DRAIN) { E.fused(acc, cur, wr, wc, fr, fq, lds, wid, lane); S.done(cur); }
#undef PG8_SA
#undef PG8_SB
#undef PG8_STAGE
#undef PG8_LDA
#undef PG8_LDB
#undef PG8_MMA
#undef PG8_WAIT_V
#undef PG8_WAIT_L
#undef PG8_BAR
#undef PG8_SCHED
}
}

constexpr int SEQ = 16384, DM = 4096, DEPTH = 4, HYW = 2048, SSW = 2048, NHEAD = 32, HDIM = 64, NGRP = 8, NST = 128, QCH = 256, NCH = SEQ / QCH;
constexpr int NIN = 12320, DFF = 16384, XBCW = 4096, PSW = 6144, NTAP = 8192;
constexpr float EPS = 1e-5f;
enum { I_X = 0, I_NMG, I_WIN, I_HCW, I_HCB, I_PW1, I_PB1, I_PW2, I_PB2, I_PW3, I_PB3, I_SF, I_WOUTF, I_SKIP, I_HOG, I_SCW, I_SCB, I_ALOG, I_DTB, I_SD, I_SOG, I_WO, I_NLG, I_WUP, I_WDN, I_FNG, N_INPUTS };

constexpr size_t MiB = 1u << 20;
constexpr size_t WS_CTL = 0, CTL_ZERO_BYTES = 1 * MiB;
constexpr size_t WS_TW = 1 * MiB;
constexpr size_t WS_PW = WS_TW + 131072;
constexpr size_t WS_WIN = 2 * MiB;
constexpr size_t WS_WOUT = 100 * MiB;
constexpr size_t WS_WUP = 132 * MiB;
constexpr size_t WS_WDN = 260 * MiB;
constexpr size_t WS_XN = 388 * MiB;
constexpr size_t WS_PT = 516 * MiB;
constexpr size_t WS_PS = 708 * MiB;
constexpr size_t WS_XBC = 900 * MiB;
constexpr size_t WS_H3 = 1028 * MiB;
constexpr size_t WS_DTF = 1032 * MiB, WS_DTB = 1034 * MiB, WS_ACS = 1036 * MiB, WS_RB = 1038 * MiB, WS_SSQ = 1040 * MiB, WS_DTRAW = 1042 * MiB;
constexpr size_t WS_SSQA = 1028 * MiB + 2 * MiB, WS_SSQB = WS_SSQA + 65536;
constexpr size_t WS_PARTA = 2900 * MiB, WS_PARTB = 2904 * MiB;
constexpr size_t WS_HT = 1044 * MiB;
constexpr size_t WS_Z2T = 1556 * MiB;
constexpr size_t WS_S = 1684 * MiB;
constexpr size_t WS_SIN = 1812 * MiB;
constexpr size_t WS_YMIX = 1876 * MiB;
constexpr size_t WS_X = 2004 * MiB;
constexpr size_t WS_H = 2260 * MiB;
constexpr size_t WS_GSCR = 2772 * MiB;
constexpr size_t GSCR_PER_WG = 17 * 512 * 16 + 16 * 512 * 8;
constexpr size_t WS_DUMMY = 2912 * MiB;
constexpr size_t WS_END = 2908 * MiB;
constexpr int CW_BAR = 4096;

constexpr int LDS_BYTES = 163840;
constexpr int MISC_OFF = LDS_BYTES - 256;
constexpr int FFT_BYTES = (16384 + 512) * 8;
constexpr int RED_OFF = FFT_BYTES;

#define GAS __attribute__((address_space(1)))
#define LAS __attribute__((address_space(3)))
typedef unsigned short bf16;
typedef unsigned v4u __attribute__((ext_vector_type(4)));
typedef unsigned v2u __attribute__((ext_vector_type(2)));
typedef float f32x4 __attribute__((ext_vector_type(4)));
typedef float f32x2 __attribute__((ext_vector_type(2)));
typedef float f32x16 __attribute__((ext_vector_type(16)));
typedef short bf16x8 __attribute__((ext_vector_type(8)));
typedef short bf16x4 __attribute__((ext_vector_type(4)));
#define LDS_WAIT() asm volatile("s_waitcnt lgkmcnt(0)" ::: "memory")
__device__ __forceinline__ float bf2f(unsigned short h) { return __uint_as_float((unsigned)h << 16); }
__device__ __forceinline__ float bflo(unsigned w) { return __uint_as_float(w << 16); }
__device__ __forceinline__ float bfhi(unsigned w) { return __uint_as_float(w & 0xffff0000u); }
__device__ __forceinline__ unsigned pk2(float lo, float hi) { return pg8::cvt_pk_bf16(lo, hi); }
__device__ __forceinline__ float wave_sum(float v) {
#pragma unroll
    for (int o = 1; o < 64; o <<= 1) v += __shfl_xor(v, o);
    return v;
}
__device__ __forceinline__ float rdlane(float v, int l) { return __int_as_float(__builtin_amdgcn_readlane(__float_as_int(v), l)); }
__device__ __forceinline__ float silu_f(float x) { return x * __builtin_amdgcn_rcpf(1.0f + __expf(-x)); }
__device__ __forceinline__ float softplus_f(float x) { return fmaxf(x, 0.f) + log1pf(expf(-fabsf(x))); }

#define XB_TMO      128
#define XB_XCNT(j)  (256  + 64 * (j))
#define XB_XSUB(j)  (1280 + 64 * (j))
#define XB_XGEN(j)  (2304 + 64 * (j))
#define XB_TOP      3328
#define XB_TOPGEN   3392
#define XCD_BAR_WORDS 3456
#define XB_SPIN_CAP (1u << 18)

__device__ __forceinline__ unsigned xb_ld(unsigned* p)              { return __hip_atomic_load(p, __ATOMIC_RELAXED, __HIP_MEMORY_SCOPE_AGENT); }
__device__ __forceinline__ unsigned xb_add(unsigned* p, unsigned v) { return __hip_atomic_fetch_add(p, v, __ATOMIC_RELAXED, __HIP_MEMORY_SCOPE_AGENT); }
__device__ __forceinline__ unsigned xb_xcc_id() { return (unsigned)__builtin_amdgcn_s_getreg((3 << 11) | 20) & 0xFu; }
#define XB_SPIN(cond, bar) do { unsigned _sp = 0; while (cond) { __builtin_amdgcn_s_sleep(1); \
    if ((++_sp & 255u) == 0u) { if (xb_ld(&(bar)[XB_TMO])) break; if (_sp > XB_SPIN_CAP) { atomicAdd(&(bar)[XB_TMO], 1u); break; } } } } while (0)

struct XcdBarrier {
    unsigned* bar; unsigned x;
    volatile LAS unsigned* st;
};

__device__ __forceinline__ XcdBarrier xcd_barrier_post(unsigned* bar, volatile LAS unsigned* st) {
    XcdBarrier b; b.bar = bar; b.x = xb_xcc_id(); b.st = st;
    if (threadIdx.x == 0) (void)xb_add(&bar[XB_XCNT(b.x)], 1u);
    return b;
}
__device__ __forceinline__ void xcd_barrier_complete(unsigned* bar, unsigned x, unsigned& nloc, unsigned& nx) {
    const unsigned G = gridDim.x * gridDim.y * gridDim.z;
    unsigned sum, cnt, mine, sp = 0u;
    for (;;) {
        sum = 0u; cnt = 0u; mine = 0u;
#pragma unroll
        for (unsigned j = 0; j < 16; ++j) { const unsigned c = xb_ld(&bar[XB_XCNT(j)]); sum += c; cnt += (c > 0u) ? 1u : 0u; mine = (j == x) ? c : mine; }
        if (sum == G) break;
        __builtin_amdgcn_s_sleep(1);
        if ((++sp & 255u) == 0u) { if (xb_ld(&bar[XB_TMO])) break; if (sp > XB_SPIN_CAP) { atomicAdd(&bar[XB_TMO], 1u); break; } }
    }
    nloc = mine > 0u ? mine : 1u; nx = cnt > 0u ? cnt : 1u;
}

__device__ __forceinline__ void xcd_barrier(const XcdBarrier& b) {
    asm volatile("s_waitcnt vmcnt(0)" ::: "memory");
    __syncthreads();
    if (threadIdx.x == 0) {
        unsigned* bar = b.bar;
        __builtin_amdgcn_s_waitcnt(0);
        unsigned nloc = b.st[0], nx = b.st[1];
        if (nloc == 0u) { xcd_barrier_complete(bar, b.x, nloc, nx); b.st[0] = nloc; b.st[1] = nx; }
        const unsigned old = xb_add(&bar[XB_XSUB(b.x)], 1u);
        const unsigned gen = old / nloc;
        if (old + 1u == (gen + 1u) * nloc) {
            __builtin_amdgcn_fence(__ATOMIC_RELEASE, "agent");
            asm volatile("s_waitcnt vmcnt(0)" ::: "memory");
            const unsigned og = xb_add(&bar[XB_TOP], 1u);
            const unsigned tg = og / nx;
            if (og + 1u == (tg + 1u) * nx) xb_add(&bar[XB_TOPGEN], 1u);
            else XB_SPIN(xb_ld(&bar[XB_TOPGEN]) == tg, bar);
            __builtin_amdgcn_fence(__ATOMIC_ACQUIRE, "agent");
            xb_add(&bar[XB_XGEN(b.x)], 1u);
            asm volatile("s_waitcnt vmcnt(0)" ::: "memory");
        } else {
            XB_SPIN(xb_ld(&bar[XB_XGEN(b.x)]) == gen, bar);
            __builtin_amdgcn_fence(__ATOMIC_ACQUIRE, "agent");
            asm volatile("s_waitcnt vmcnt(0)" ::: "memory");
        }
    }
    __syncthreads();
}

__device__ __forceinline__ void transpose_item(const float* W, int K, int N, bf16* WT, LAS float* scr, int item, int lane, const float* gk) {
    const int nblk = N / 32, kb = item / nblk, nb = item % nblk, k0 = 64 * kb, n0 = 32 * nb;
#pragma unroll
    for (int i = 0; i < 32; ++i) { const int kk = 2 * i + (lane >> 5); scr[kk * 33 + (lane & 31)] = W[(size_t)(k0 + kk) * N + n0 + (lane & 31)]; }
    LDS_WAIT(); asm volatile("" ::: "memory");
    const int c = lane & 7;
    f32x4 g0 = (f32x4){1.f, 1.f, 1.f, 1.f}, g1 = g0;
    if (gk) { g0 = *(const f32x4*)(gk + k0 + 8 * c); g1 = *(const f32x4*)(gk + k0 + 8 * c + 4); }
#pragma unroll
    for (int j = 0; j < 4; ++j) { const int n = (lane >> 3) + 8 * j; const LAS float* s = scr + (8 * c) * 33 + n;
        v4u o; o.x = pk2(s[0 * 33] * g0.x, s[1 * 33] * g0.y); o.y = pk2(s[2 * 33] * g0.z, s[3 * 33] * g0.w); o.z = pk2(s[4 * 33] * g1.x, s[5 * 33] * g1.y); o.w = pk2(s[6 * 33] * g1.z, s[7 * 33] * g1.w);
        *(v4u*)(WT + (size_t)(n0 + n) * K + k0 + 8 * c) = o; }
    LDS_WAIT(); asm volatile("" ::: "memory");
}
template <bool TO_BF16>
__device__ __forceinline__ void rms_row(const float* xrow, const float* g, void* orow, int lane) {
    const f32x4* xr = (const f32x4*)xrow + lane;
    f32x4 v[16]; float s = 0.f;
#pragma unroll
    for (int j = 0; j < 16; ++j) { v[j] = xr[64 * j]; s += (v[j].x * v[j].x + v[j].y * v[j].y) + (v[j].z * v[j].z + v[j].w * v[j].w); }
    const float r = 1.0f / sqrtf(wave_sum(s) * (1.f / DM) + EPS);
    const f32x4* gr = (const f32x4*)g + lane;
#pragma unroll
    for (int j = 0; j < 16; ++j) { const f32x4 gg = gr[64 * j]; const f32x4 o = v[j] * r * gg;
        if (TO_BF16) { v2u w; w.x = pk2(o.x, o.y); w.y = pk2(o.z, o.w); ((v2u*)orow)[lane + 64 * j] = w; }
        else ((f32x4*)orow)[lane + 64 * j] = o; }
}
__device__ __forceinline__ void rms_row_b(const bf16* xrow, const float* g, float* orow, int lane) {
    const v4u* xr = (const v4u*)xrow + lane;
    v4u v[8]; float s = 0.f;
#pragma unroll
    for (int j = 0; j < 8; ++j) { v[j] = xr[64 * j];
#pragma unroll
        for (int e = 0; e < 4; ++e) { const float a = bflo(v[j][e]), b = bfhi(v[j][e]); s += a * a + b * b; } }
    const float r = 1.0f / sqrtf(wave_sum(s) * (1.f / DM) + EPS);
#pragma unroll
    for (int j = 0; j < 8; ++j) { const int c0 = (lane + 64 * j) * 8;
        const f32x4 g0 = *(const f32x4*)(g + c0), g1 = *(const f32x4*)(g + c0 + 4);
        f32x4 o0, o1;
        o0.x = bflo(v[j].x) * r * g0.x; o0.y = bfhi(v[j].x) * r * g0.y; o0.z = bflo(v[j].y) * r * g0.z; o0.w = bfhi(v[j].y) * r * g0.w;
        o1.x = bflo(v[j].z) * r * g1.x; o1.y = bfhi(v[j].z) * r * g1.y; o1.z = bflo(v[j].w) * r * g1.z; o1.w = bfhi(v[j].w) * r * g1.w;
        *(f32x4*)(orow + c0) = o0; *(f32x4*)(orow + c0 + 4) = o1; }
}
__device__ __forceinline__ void rstd_reduce(const float* part, float* rstd, int row) {
    float s = 0.f;
#pragma unroll 16
    for (int j = 0; j < 64; ++j) s += part[(size_t)j * SEQ + row];
    rstd[row] = pg8::rstd_of(s);
}
__device__ __forceinline__ void prep_row(const float* xrow, bf16* orow, float* rstd, int lane) {
    const f32x4* xr = (const f32x4*)xrow + lane; float s = 0.f;
#pragma unroll
    for (int j = 0; j < 16; ++j) { const f32x4 v = xr[64 * j]; s += (v.x * v.x + v.y * v.y) + (v.z * v.z + v.w * v.w); v2u w; w.x = pk2(v.x, v.y); w.y = pk2(v.z, v.w); ((v2u*)orow)[lane + 64 * j] = w; }
    s = wave_sum(s);
    if (lane == 0) *rstd = pg8::rstd_of(s);
}
__device__ __forceinline__ void posmlp_rows8(int t0, int ts, const float* w1, const float* b1, const float* w2, const float* b2, const float* w3, const float* b3, const float* sf, bf16* H3, int lane) {
    float zf[8], acc[8], h[8];
#pragma unroll
    for (int r = 0; r < 8; ++r) { const int t = t0 + r * ts;
        const float tl = (float)t / 16383.0f;
        const float wang = (6.283185307179586f * (float)t) / 16384.0f;
        float z = 0.f;
        if (lane == 0) z = tl;
        else if (lane <= 32) { const int i = (lane - 1) & 15; const float sfr = (float)i / 15.0f; const float f = 1e-4f * (1.0f - sfr) + 15.0f * sfr; const float ang = f * wang; z = (lane <= 16) ? cosf(ang) : -sinf(ang); }
        zf[r] = z; }
    { const float b = b1[lane];
#pragma unroll
      for (int r = 0; r < 8; ++r) acc[r] = b; }
#pragma unroll 3
    for (int f = 0; f < 33; ++f) { const float w = w1[f * 64 + lane];
#pragma unroll
        for (int r = 0; r < 8; ++r) acc[r] += rdlane(zf[r], f) * w; }
    { const float s_ = sf[lane], b = b2[lane];
#pragma unroll
      for (int r = 0; r < 8; ++r) { h[r] = sinf(s_ * acc[r]); acc[r] = b; } }
#pragma unroll 4
    for (int i = 0; i < 64; ++i) { const float w = w2[i * 64 + lane];
#pragma unroll
        for (int r = 0; r < 8; ++r) acc[r] += rdlane(h[r], i) * w; }
    { const float s_ = sf[64 + lane], b = b3[lane];
#pragma unroll
      for (int r = 0; r < 8; ++r) { h[r] = sinf(s_ * acc[r]); acc[r] = b; } }
#pragma unroll 4
    for (int i = 0; i < 64; ++i) { const float w = w3[i * 64 + lane];
#pragma unroll
        for (int r = 0; r < 8; ++r) acc[r] += rdlane(h[r], i) * w; }
    { const float s_ = sf[128 + lane];
#pragma unroll
      for (int r = 0; r < 8; ++r) { const int t = t0 + r * ts; const float o = sinf(s_ * acc[r]); if (t < SEQ) H3[(size_t)t * 64 + lane] = (bf16)(pk2(o, o) & 0xffffu); } }
}
__device__ __forceinline__ f32x4 mfma16_t(bf16x8 a, bf16x8 b, f32x4 c) { return __builtin_amdgcn_mfma_f32_16x16x32_bf16(a, b, c, 0, 0, 0); }
__device__ __forceinline__ void taps_gemm(const float* wout, const bf16* h3, bf16* HT, int gw, int NGW, int lane) {
    const int g = lane >> 4, li = lane & 15;
    const int ngroups = NGW / 256;
    if (ngroups == 0) return;
    const int nblk = gw % 256, tg = gw / 256;
    if (tg >= ngroups) return;
    const int n0 = 32 * nblk, steps_per = (SEQ / 16) / ngroups;
    const bool bwd = ((n0 >> 11) & 1) != 0;
    bf16x8 wf[2][2];
#pragma unroll
    for (int nt = 0; nt < 2; ++nt)
#pragma unroll
        for (int ks = 0; ks < 2; ++ks) { float w[8];
#pragma unroll
            for (int j = 0; j < 8; ++j) w[j] = wout[(size_t)(32 * ks + 8 * g + j) * NTAP + n0 + 16 * nt + li];
            v4u p; p.x = pk2(w[0], w[1]); p.y = pk2(w[2], w[3]); p.z = pk2(w[4], w[5]); p.w = pk2(w[6], w[7]); wf[nt][ks] = __builtin_bit_cast(bf16x8, p); }
    float ad[2];
#pragma unroll
    for (int nt = 0; nt < 2; ++nt) { const int c = (n0 + 16 * nt + li) & 2047; const float sfr = (float)c / 2047.0f;
        ad[nt] = fabsf(-120.39728043259361f * (1.0f - sfr) + 40.546510810816436f * sfr); }
    const int off = bwd ? 1 : 0;
    const int steps32 = (SEQ / 32) / ngroups;
    const int lrow = 8 * (li >> 2) + (li & 3);
#pragma unroll 2
    for (int i = 0; i < steps32; ++i) {
        const int t0 = 32 * (tg * steps32 + i);
        bf16x8 a[2][2];
#pragma unroll
        for (int tt = 0; tt < 2; ++tt) { const int trow = t0 + off + lrow + 4 * tt;
            const bf16x8* hr = (const bf16x8*)(h3 + (size_t)(trow < SEQ ? trow : SEQ - 1) * 64 + 8 * g); a[tt][0] = hr[0]; a[tt][1] = hr[4]; }
        const float tl0 = (float)(t0 + off + 8 * g) / 16383.0f;
#pragma unroll
        for (int nt = 0; nt < 2; ++nt) {
            float v[8];
#pragma unroll
            for (int tt = 0; tt < 2; ++tt) { f32x4 d = (f32x4){0.f, 0.f, 0.f, 0.f};
                d = mfma16_t(a[tt][0], wf[nt][0], d); d = mfma16_t(a[tt][1], wf[nt][1], d);
#pragma unroll
                for (int r = 0; r < 4; ++r) v[4 * tt + r] = d[r] * __expf(-(tl0 + (float)(4 * tt + r) / 16383.0f) * ad[nt]); }
            bf16* rowp = HT + (size_t)(n0 + 16 * nt + li) * SEQ;
            v4u o;
            if (!bwd) { o.x = pk2(v[0], v[1]); o.y = pk2(v[2], v[3]); o.z = pk2(v[4], v[5]); o.w = pk2(v[6], v[7]); *(v4u*)(rowp + t0 + 8 * g) = o; }
            else { if (t0 + 8 * g + 8 == SEQ) v[7] = 0.f;
                   o.x = pk2(v[7], v[6]); o.y = pk2(v[5], v[4]); o.z = pk2(v[3], v[2]); o.w = pk2(v[1], v[0]); *(v4u*)(rowp + (SEQ - t0 - 8 * g - 8)) = o; }
        }
    }
}

#define CMULV(xr, xi, br, bi) do { const float _t = (xr) * (br) - (xi) * (bi); (xi) = (xr) * (bi) + (xi) * (br); (xr) = _t; } while (0)
#define DFT4V(r0, i0, r1, i1, r2, i2, r3, i3) do { \
    const f32x2 t0r = (r0) + (r2), t0i = (i0) + (i2), t1r = (r0) - (r2), t1i = (i0) - (i2); \
    const f32x2 t2r = (r1) + (r3), t2i = (i1) + (i3), dr = (r1) - (r3), di = (i1) - (i3); \
    (r0) = t0r + t2r; (i0) = t0i + t2i; (r2) = t0r - t2r; (i2) = t0i - t2i; \
    (r1) = t1r + di; (i1) = t1i - dr; (r3) = t1r - di; (i3) = t1i + dr; } while (0)
#define CMULVV(xr, xi, br, bi) do { const f32x2 _t = (xr) * (br) - (xi) * (bi); (xi) = (xr) * (bi) + (xi) * (br); (xr) = _t; } while (0)
__device__ __forceinline__ void dft16(f32x2 (&ar)[16], f32x2 (&ai)[16]) {
    const float C1 = 0.92387953251128674f, S1 = 0.38268343236508977f, HH = 0.70710678118654752f;
#pragma unroll
    for (int n2 = 0; n2 < 4; ++n2) DFT4V(ar[n2], ai[n2], ar[4 + n2], ai[4 + n2], ar[8 + n2], ai[8 + n2], ar[12 + n2], ai[12 + n2]);
    CMULVV(ar[5], ai[5], C1, -S1);
    CMULVV(ar[9], ai[9], HH, -HH);
    CMULVV(ar[13], ai[13], S1, -C1);
    CMULVV(ar[6], ai[6], HH, -HH);
    { const f32x2 t = ar[10]; ar[10] = ai[10]; ai[10] = -t; }
    CMULVV(ar[14], ai[14], -HH, -HH);
    CMULVV(ar[7], ai[7], S1, -C1);
    CMULVV(ar[11], ai[11], -HH, -HH);
    CMULVV(ar[15], ai[15], -C1, S1);
#pragma unroll
    for (int k1 = 0; k1 < 4; ++k1) DFT4V(ar[4 * k1], ai[4 * k1], ar[4 * k1 + 1], ai[4 * k1 + 1], ar[4 * k1 + 2], ai[4 * k1 + 2], ar[4 * k1 + 3], ai[4 * k1 + 3]);
}
#define CMULT(xr, xi, br, bi) do { const auto _t = (xr) * (br) - (xi) * (bi); (xi) = (xr) * (bi) + (xi) * (br); (xr) = _t; } while (0)
template <class T>
__device__ __forceinline__ void twiddle16(f32x2 (&ar)[16], f32x2 (&ai)[16], T wr, T wi) {
    const T w2r = wr * wr - wi * wi, w2i = 2.f * wr * wi;
    const T w3r = w2r * wr - w2i * wi, w3i = w2r * wi + w2i * wr;
    const T w4r = w2r * w2r - w2i * w2i, w4i = 2.f * w2r * w2i;
    CMULT(ar[1], ai[1], wr, wi); CMULT(ar[2], ai[2], w2r, w2i); CMULT(ar[3], ai[3], w3r, w3i);
    T br = w4r, bi = w4i;
#pragma unroll
    for (int m = 1; m < 4; ++m) {
        CMULT(ar[4 * m], ai[4 * m], br, bi);
        { T tr = br, ti = bi; CMULT(tr, ti, wr, wi); CMULT(ar[4 * m + 1], ai[4 * m + 1], tr, ti); }
        { T tr = br, ti = bi; CMULT(tr, ti, w2r, w2i); CMULT(ar[4 * m + 2], ai[4 * m + 2], tr, ti); }
        { T tr = br, ti = bi; CMULT(tr, ti, w3r, w3i); CMULT(ar[4 * m + 3], ai[4 * m + 3], tr, ti); }
        CMULT(br, bi, w4r, w4i);
    }
}
constexpr int TWL_OFF = RED_OFF + 256;
__device__ __forceinline__ void fft_fill_twl(const f32x2* TW, const f32x2* PW, LAS unsigned char* lds, int tid) {
    LAS f32x2* twl = (LAS f32x2*)(lds + TWL_OFF);
    twl[tid] = PW[tid]; twl[512 + tid] = TW[16 * (tid & 31)]; twl[1024 + tid] = TW[tid];
}
__device__ __forceinline__ void radix32_combine(const f32x2 (&Dr)[16], const f32x2 (&Di)[16], f32x2 (&X)[32]) {
#pragma unroll
    for (int k = 0; k < 16; ++k) { const int s = 4 * (k & 3) + (k >> 2);
        const float cr = __builtin_cosf(6.28318530717958647692f * (float)k / 32.0f), ci = -__builtin_sinf(6.28318530717958647692f * (float)k / 32.0f);
        const float tr = cr * Dr[s].y - ci * Di[s].y, ti = cr * Di[s].y + ci * Dr[s].y;
        X[k] = (f32x2){Dr[s].x + tr, Di[s].x + ti}; X[k + 16] = (f32x2){Dr[s].x - tr, Di[s].x - ti}; }
}
__device__ __forceinline__ void fft16k(f32x2 (&Rr)[16], f32x2 (&Ri)[16], LAS f32x2* fb, const LAS f32x2* twl, int tid_in) {
    int tid = tid_in; asm volatile("" : "+v"(tid));
    const int j = tid;
    f32x2 X[32];
    __syncthreads();
    dft16(Rr, Ri);
    radix32_combine(Rr, Ri, X);
#pragma unroll
    for (int k = 0; k < 32; ++k) fb[33 * j + k] = X[k];
    __syncthreads();
    {
        const f32x2 w = twl[512 + tid];
#pragma unroll
        for (int s = 0; s < 16; ++s) { const f32x2 v0 = fb[j + (j >> 5) + 528 * (2 * s)], v1 = fb[j + (j >> 5) + 528 * (2 * s + 1)]; Rr[s] = (f32x2){v0.x, v1.x}; Ri[s] = (f32x2){v0.y, v1.y}; }
        const float w2r = w.x * w.x - w.y * w.y, w2i = 2.f * w.x * w.y;
        twiddle16<float>(Rr, Ri, w2r, w2i);
        const f32x2 ur = (f32x2){1.f, w.x}, ui = (f32x2){0.f, w.y};
#pragma unroll
        for (int s = 0; s < 16; ++s) CMULT(Rr[s], Ri[s], ur, ui);
        dft16(Rr, Ri);
        radix32_combine(Rr, Ri, X);
    }
    __syncthreads();
#pragma unroll
    for (int k = 0; k < 32; ++k) fb[(j >> 5) * 1056 + (j & 31) + 33 * k] = X[k];
    __syncthreads();
    {
        const f32x2 w0 = twl[1024 + tid];
        const float c16 = 0.98078528040323043f, s16 = 0.19509032201612825f;
        const f32x2 wr = (f32x2){w0.x, w0.x * c16 + w0.y * s16}, wi = (f32x2){w0.y, w0.y * c16 - w0.x * s16};
#pragma unroll
        for (int r = 0; r < 16; ++r) { const f32x2 v0 = fb[j + (j >> 5) + 1056 * r], v1 = fb[j + (j >> 5) + 528 + 1056 * r]; Rr[r] = (f32x2){v0.x, v1.x}; Ri[r] = (f32x2){v0.y, v1.y}; }
        twiddle16<f32x2>(Rr, Ri, wr, wi);
        dft16(Rr, Ri);
#pragma unroll
        for (int k = 0; k < 16; ++k) { const int s = 4 * (k & 3) + (k >> 2); if (k < s) { const f32x2 tr = Rr[k], ti = Ri[k]; Rr[k] = Rr[s]; Ri[k] = Ri[s]; Rr[s] = tr; Ri[s] = ti; } }
    }
}
typedef unsigned v3u_a4 __attribute__((ext_vector_type(3), aligned(4)));
struct ConvRaw { unsigned lo, hi, nx; };
__device__ __forceinline__ ConvRaw conv_load(const bf16* row, int m) {
    const v3u_a4 v = *(const v3u_a4*)(row + (m > 0 ? 2 * m - 2 : 0));
    ConvRaw r; r.lo = (m > 0) ? v.x : 0u; r.hi = (m > 0) ? v.y : v.x;
    const unsigned n3 = (m > 0) ? v.z : v.y;
    r.nx = (m < SEQ / 2 - 1) ? (n3 & 0xffffu) : 0u;
    return r;
}
__device__ __forceinline__ void conv_apply(const ConvRaw& r, float w0, float w1, float w2, float b, float& u0, float& u1) {
    const float pm = bfhi(r.lo), p0 = bflo(r.hi), p1 = bfhi(r.hi), pp = __uint_as_float(r.nx << 16);
    u0 = w0 * pm + w1 * p0 + w2 * p1 + b; u1 = w0 * p0 + w1 * p1 + w2 * pp + b;
}
#define FFT_CALL() do { f32x2 Rr_[16], Ri_[16]; \
    _Pragma("unroll") for (int e_ = 0; e_ < 16; ++e_) { Rr_[e_] = (f32x2){re[2 * e_], re[2 * e_ + 1]}; Ri_[e_] = (f32x2){im[2 * e_], im[2 * e_ + 1]}; } \
    fft16k(Rr_, Ri_, fb, TW, tid_in); \
    _Pragma("unroll") for (int e_ = 0; e_ < 16; ++e_) { re[2 * e_] = Rr_[e_].x; re[2 * e_ + 1] = Rr_[e_].y; im[2 * e_] = Ri_[e_].x; im[2 * e_ + 1] = Ri_[e_].y; } } while (0)
__device__ __forceinline__ f32x2 pw_q(f32x2 wt, int q) {
    const float cr = __builtin_cosf(3.14159265358979323846f * (float)q / 32.0f), ci = -__builtin_sinf(3.14159265358979323846f * (float)q / 32.0f);
    return (f32x2){wt.x * cr - wt.y * ci, wt.x * ci + wt.y * cr};
}
__device__ __forceinline__ void hyena_channel(int c, const bf16* PT, const bf16* HT, const float* cw, const float* cb, const float* skip, bf16* Z2T,
                                              f32x4* gscr, LAS unsigned char* lds, int tid_in) {
#define RETID() int tid = tid_in; asm volatile("" : "+v"(tid))
    LAS f32x2* fb = (LAS f32x2*)lds;
    LAS float* red = (LAS float*)(lds + RED_OFF);
    const LAS f32x2* TW = (const LAS f32x2*)(lds + TWL_OFF);
    const int lane = tid_in & 63, wave = tid_in >> 6;
    float sr[16], si[16];
    {
        RETID();
        const int col = 2 * HYW + c; const float w0 = cw[col], w1 = cw[3 * HYW + col], w2 = cw[6 * HYW + col], b = cb[col];
        const bf16* row = PT + (size_t)col * SEQ;
#pragma unroll
        for (int q = 0; q < 16; ++q) { const ConvRaw r = conv_load(row, tid + 512 * q); conv_apply(r, w0, w1, w2, b, sr[q], si[q]); }
    }
#pragma unroll 1
    for (int o = 0; o < 2; ++o) {
        float re[32], im[32];
        float Agr[17], Agi[17], Bgr[17], Bgi[17];
        {
            RETID();
            const bf16* hf = HT + (size_t)(o * 4096 + c) * SEQ;
            const bf16* hb = HT + (size_t)(o * 4096 + 2048 + c) * SEQ;
            float l1 = 0.f;
#pragma unroll
            for (int q = 0; q < 32; ++q) { const int m = tid + 512 * q;
                const unsigned w = (q < 16) ? *(const unsigned*)(hf + 2 * m) : *(const unsigned*)(hb + 2 * m - SEQ);
                re[q] = bflo(w); im[q] = bfhi(w); l1 += fabsf(re[q]) + fabsf(im[q]); }
            l1 = wave_sum(l1);
            __syncthreads();
            if (lane == 0) red[wave] = l1;
            __syncthreads();
            float tot = 0.f;
#pragma unroll
            for (int w = 0; w < 8; ++w) tot += red[w];
            const float scale = 1.0f / (8.0f * (float)SEQ * tot);
            FFT_CALL();
            __syncthreads();
          { RETID();
#pragma unroll
            for (int q = 0; q < 32; ++q) fb[tid + (tid >> 5) + 528 * q] = (f32x2){re[q], im[q]}; }
            __syncthreads();
          { RETID(); const f32x2 wt = TW[tid];
#pragma unroll
            for (int q = 0; q < 17; ++q) {
                const int k = tid + 512 * q;
                if (q < 16 || tid == 0) {
                    const int kp = (SEQ - k) & (SEQ - 1);
                    f32x2 zk; if (q < 16) zk = (f32x2){re[q], im[q]}; else zk = fb[(SEQ / 2) + (SEQ / 64)];
                    const f32x2 zp = fb[kp + (kp >> 5)];
                    const f32x2 w = (q < 16) ? pw_q(wt, q) : (f32x2){0.f, -1.f};
                    const float er = zk.x + zp.x, ei = zk.y - zp.y, orr = zk.y + zp.y, oi = zp.x - zk.x;
                    const float wor = w.x * orr - w.y * oi, woi = w.x * oi + w.y * orr;
                    Agr[q] = (er + wor) * scale; Agi[q] = (ei + woi) * scale; Bgr[q] = (er - wor) * scale; Bgi[q] = (ei - woi) * scale;
                } else { Agr[q] = 0.f; Agi[q] = 0.f; Bgr[q] = 0.f; Bgi[q] = 0.f; }
            } }
        }
#pragma unroll
        for (int q = 0; q < 16; ++q) { re[q] = sr[q]; im[q] = si[q]; re[q + 16] = 0.f; im[q + 16] = 0.f; }
        FFT_CALL();
        __syncthreads();
      { RETID();
#pragma unroll
        for (int q = 0; q < 32; ++q) fb[tid + (tid >> 5) + 528 * q] = (f32x2){re[q], im[q]}; }
        __syncthreads();
      { RETID(); const f32x2 wt = TW[tid];
#pragma unroll
        for (int q = 0; q < 17; ++q) {
            const int k = tid + 512 * q;
            if (q < 16 || tid == 0) {
                const int kp = (SEQ - k) & (SEQ - 1);
                f32x2 zk; if (q < 16) zk = (f32x2){re[q], im[q]}; else zk = fb[(SEQ / 2) + (SEQ / 64)];
                const f32x2 zp = fb[kp + (kp >> 5)];
                const f32x2 w = (q < 16) ? pw_q(wt, q) : (f32x2){0.f, -1.f};
                const float er = zk.x + zp.x, ei = zk.y - zp.y, orr = zk.y + zp.y, oi = zp.x - zk.x;
                const float wor = w.x * orr - w.y * oi, woi = w.x * oi + w.y * orr;
                const float ar = er + wor, ai = ei + woi, br = er - wor, bi = ei - woi;
                const float aar = ar * Agr[q] - ai * Agi[q], aai = ar * Agi[q] + ai * Agr[q];
                const float bbr = br * Bgr[q] - bi * Bgi[q], bbi = br * Bgi[q] + bi * Bgr[q];
                const float eyr = aar + bbr, eyi = aai + bbi, dyr = aar - bbr, dyi = aai - bbi;
                const float oyr = dyr * w.x + dyi * w.y, oyi = dyi * w.x - dyr * w.y;
                if (q < 16) { re[q] = eyr - oyi; im[q] = -eyi - oyr; fb[kp + (kp >> 5)] = (f32x2){eyr + oyi, eyi - oyr}; }
                else fb[(SEQ / 2) + (SEQ / 64)] = (f32x2){eyr - oyi, -eyi - oyr};
            }
        } }
        __syncthreads();
      { RETID();
#pragma unroll
        for (int q = 16; q < 32; ++q) { const f32x2 v = fb[tid + (tid >> 5) + 528 * q]; re[q] = v.x; im[q] = v.y; } }
        ConvRaw graw[16];
      { RETID(); const bf16* grow = PT + (size_t)(o * HYW + c) * SEQ;
#pragma unroll
        for (int q = 0; q < 16; ++q) graw[q] = conv_load(grow, tid + 512 * q); }
        FFT_CALL();
        {
            RETID();
            const int col = o * HYW + c; const float w0 = cw[col], w1 = cw[3 * HYW + col], w2 = cw[6 * HYW + col], b = cb[col];
            const float sk = skip[o * HYW + c]; bf16* orow = Z2T + (size_t)c * SEQ;
#pragma unroll
            for (int q = 0; q < 16; ++q) { float g0, g1; conv_apply(graw[q], w0, w1, w2, b, g0, g1);
                const float o0 = g0 * (re[q] + sk * sr[q]), o1 = g1 * (-im[q] + sk * si[q]);
                sr[q] = o0; si[q] = o1;
                if (o == 1) *(unsigned*)(orow + 2 * (tid + 512 * q)) = pk2(o0, o1); }
        }
    }
#undef RETID
}

typedef unsigned short u16;
__device__ __forceinline__ f32x4 mfma16(bf16x8 a, bf16x8 b, f32x4 c) { return __builtin_amdgcn_mfma_f32_16x16x32_bf16(a, b, c, 0, 0, 0); }

__device__ __forceinline__ void ssm_conv_item(const bf16* __restrict__ PS, const float* cw, const float* cb, bf16* __restrict__ XBC, int item) {
    const int oct = item & 511, rb = item >> 9, ch = 8 * oct, t0 = 32 * rb;
    float w0[8], w1[8], w2[8], bb[8];
#pragma unroll
    for (int e = 0; e < 8; ++e) { w0[e] = cw[ch + e]; w1[e] = cw[XBCW + ch + e]; w2[e] = cw[2 * XBCW + ch + e]; bb[e] = cb[ch + e]; }
    const bf16* src = PS + 2048 + ch;
    v4u prev = (v4u){0u, 0u, 0u, 0u}, cur;
    if (t0 > 0) prev = *(const v4u*)(src + (size_t)(t0 - 1) * PSW);
    cur = *(const v4u*)(src + (size_t)t0 * PSW);
#pragma unroll 1
    for (int r8 = 0; r8 < 32; r8 += 8) {
        v4u nx[8];
#pragma unroll
        for (int i = 0; i < 8; ++i) { const int t = t0 + r8 + i + 1; nx[i] = (v4u){0u, 0u, 0u, 0u}; if (t < SEQ) nx[i] = *(const v4u*)(src + (size_t)t * PSW); }
#pragma unroll
        for (int i = 0; i < 8; ++i) {
            const v4u nxt = nx[i];
            float o[8];
#pragma unroll
            for (int e = 0; e < 4; ++e) {
                const unsigned pw = prev[e], cwd = cur[e], nw = nxt[e];
                const float x0 = w0[2 * e] * bflo(pw) + w1[2 * e] * bflo(cwd) + w2[2 * e] * bflo(nw) + bb[2 * e];
                const float x1 = w0[2 * e + 1] * bfhi(pw) + w1[2 * e + 1] * bfhi(cwd) + w2[2 * e + 1] * bfhi(nw) + bb[2 * e + 1];
                o[2 * e] = silu_f(x0); o[2 * e + 1] = silu_f(x1);
            }
            v4u ov; ov.x = pk2(o[0], o[1]); ov.y = pk2(o[2], o[3]); ov.z = pk2(o[4], o[5]); ov.w = pk2(o[6], o[7]);
            *(v4u*)(XBC + (size_t)(t0 + r8 + i) * XBCW + ch) = ov;
            prev = cur; cur = nxt;
        }
    }
}
__device__ __forceinline__ void ssm_dt_tile(int tile, const bf16* XN, const bf16* Wdt, const float* rstd, float* DTRAW, int lane) {
    const int li = lane & 15, g = lane >> 4, t0 = 16 * tile;
    f32x4 acc0 = (f32x4){0.f, 0.f, 0.f, 0.f}, acc1 = (f32x4){0.f, 0.f, 0.f, 0.f};
    const bf16* xa = XN + (size_t)(t0 + li) * DM + 8 * g;
    const bf16* wb0 = Wdt + (size_t)li * DM + 8 * g;
    const bf16* wb1 = wb0 + (size_t)16 * DM;
#pragma unroll 8
    for (int ks = 0; ks < DM / 32; ++ks) {
        const bf16x8 a = *(const bf16x8*)(xa + 32 * ks), b0 = *(const bf16x8*)(wb0 + 32 * ks), b1 = *(const bf16x8*)(wb1 + 32 * ks);
        acc0 = mfma16(a, b0, acc0); acc1 = mfma16(a, b1, acc1);
    }
#pragma unroll
    for (int r = 0; r < 4; ++r) { const float rs = rstd[t0 + 4 * g + r];
        DTRAW[(size_t)(t0 + 4 * g + r) * 32 + li] = acc0[r] * rs; DTRAW[(size_t)(t0 + 4 * g + r) * 32 + 16 + li] = acc1[r] * rs; }
}
constexpr int XT_STRIDE = 264;
constexpr int BM_STRIDE = 136;
constexpr int SSD_XT_OFF = 0, SSD_BM_OFF = 64 * XT_STRIDE * 2  , SSD_ARR_OFF = SSD_BM_OFF + 256 * BM_STRIDE * 2  , SSD_SIN_OFF = SSD_ARR_OFF + 4096  ;
static_assert(SSD_SIN_OFF + 2 * 64 * BM_STRIDE * 2 + 4 * (512 + 32) <= MISC_OFF, "SSD LDS map");
__device__ __forceinline__ void ssd_stage_xb(int c, int h, const bf16* XBC, LAS unsigned char* lds, int tid, bool newB) {
    LAS u16* XT = (LAS u16*)(lds + SSD_XT_OFF);
    LAS u16* Bm = (LAS u16*)(lds + SSD_BM_OFF);
    const int t0 = c * QCH, grp = h >> 2;
#pragma unroll
    for (int i = 0; i < 4; ++i) { const int id = tid + 512 * i, s = id & 255, pc = id >> 8;
        const v4u v = *(const v4u*)(XBC + (size_t)(t0 + s) * XBCW + h * HDIM + 8 * pc);
        const bool odd = (s & 1) != 0;
        const unsigned sx = odd ? v.x : v.z, sy = odd ? v.y : v.w;
        const unsigned rx = (unsigned)__builtin_amdgcn_update_dpp(0, (int)sx, 0xB1, 0xF, 0xF, true), ry = (unsigned)__builtin_amdgcn_update_dpp(0, (int)sy, 0xB1, 0xF, 0xF, true);
        const unsigned ex = odd ? rx : v.x, ey = odd ? ry : v.y;
        const unsigned ox = odd ? v.z : rx, oy = odd ? v.w : ry;
        const int c0 = 8 * pc + (odd ? 4 : 0), se = s & ~1;
        *(LAS unsigned*)(XT + (c0 + 0) * XT_STRIDE + se) = (ex & 0xffffu) | (ox << 16);
        *(LAS unsigned*)(XT + (c0 + 1) * XT_STRIDE + se) = (ex >> 16) | (ox & 0xffff0000u);
        *(LAS unsigned*)(XT + (c0 + 2) * XT_STRIDE + se) = (ey & 0xffffu) | (oy << 16);
        *(LAS unsigned*)(XT + (c0 + 3) * XT_STRIDE + se) = (ey >> 16) | (oy & 0xffff0000u); }
    if (newB) {
#pragma unroll
    for (int i = 0; i < 8; ++i) { const int id = tid + 512 * i, s = id >> 4, nc = id & 15;
        const v4u v = *(const v4u*)(XBC + (size_t)(t0 + s) * XBCW + SSW + grp * NST + 8 * nc);
        *(LAS v4u*)(Bm + s * BM_STRIDE + 8 * nc) = v; }
    }
}
__device__ __forceinline__ void ssd_states_unit(int c, int h_in, const bf16* XBC, const float* DTRAW, const float* alog, const float* dtbias, float* DTF, float* DTB, float* ACS, float* RB, bf16* S,
                                                LAS unsigned char* lds, int tid, bool newB) {
    const int lane = tid & 63, wave = tid >> 6, li = lane & 15, g = lane >> 4;
    LAS u16* XT = (LAS u16*)(lds + SSD_XT_OFF);
    LAS u16* Bm = (LAS u16*)(lds + SSD_BM_OFF);
    LAS float* wfa = (LAS float*)(lds + SSD_ARR_OFF);
    const int t0 = c * QCH;
    __syncthreads();
    ssd_stage_xb(c, h_in, XBC, lds, tid, newB);
    if (newB) {
        const int dir = wave & 1; const int hq = wave >> 1;
        LAS float* wf = wfa + hq * 512; LAS float* wb = wf + 256;
        const int h = (h_in & ~3) + hq;
        const float A = -expf(alog[dir * 32 + h]), bias = dtbias[dir * 32 + h];
        float dtv[4], inc[4];
#pragma unroll
        for (int e = 0; e < 4; ++e) dtv[e] = softplus_f(DTRAW[(size_t)(t0 + 4 * lane + e) * 32 + h] + bias);
        inc[0] = dtv[0] * A; inc[1] = inc[0] + dtv[1] * A; inc[2] = inc[1] + dtv[2] * A; inc[3] = inc[2] + dtv[3] * A;
        float sc = inc[3];
#pragma unroll
        for (int o = 1; o < 64; o <<= 1) { const float t = __shfl_up(sc, o); if (lane >= o) sc += t; }
        const float excl = sc - inc[3], total = rdlane(sc, 63);
#pragma unroll
        for (int e = 0; e < 4; ++e) { const int tl = 4 * lane + e; const size_t o = (size_t)(t0 + tl) * 32 + h; const float ic = excl + inc[e];
            if (dir == 0) { wf[tl] = __expf(total - ic) * dtv[e]; DTF[o] = dtv[e]; ACS[o] = ic; }
            else { const float pre = ic - dtv[e] * A; wb[tl] = __expf(pre) * dtv[e]; DTB[o] = dtv[e]; RB[o] = total - pre; } }
    }
    const int h = h_in;
    const LAS float* wf = wfa + (h & 3) * 512; const LAS float* wb = wf + 256;
    __syncthreads();
    f32x4 acc[2][4];
#pragma unroll
    for (int d = 0; d < 2; ++d)
#pragma unroll
        for (int p = 0; p < 4; ++p) acc[d][p] = (f32x4){0.f, 0.f, 0.f, 0.f};
    const int n = 16 * wave + li;
#pragma unroll 2
    for (int ks = 0; ks < 8; ++ks) {
        const int s0 = 32 * ks + 8 * g;
        float bv[8];
#pragma unroll
        for (int j = 0; j < 8; ++j) bv[j] = bf2f(Bm[(s0 + j) * BM_STRIDE + n]);
        const f32x4 wf0 = *(const LAS f32x4*)(wf + s0), wf1 = *(const LAS f32x4*)(wf + s0 + 4), wb0 = *(const LAS f32x4*)(wb + s0), wb1 = *(const LAS f32x4*)(wb + s0 + 4);
        v4u fa, fbk;
        fa.x = pk2(bv[0] * wf0.x, bv[1] * wf0.y); fa.y = pk2(bv[2] * wf0.z, bv[3] * wf0.w); fa.z = pk2(bv[4] * wf1.x, bv[5] * wf1.y); fa.w = pk2(bv[6] * wf1.z, bv[7] * wf1.w);
        fbk.x = pk2(bv[0] * wb0.x, bv[1] * wb0.y); fbk.y = pk2(bv[2] * wb0.z, bv[3] * wb0.w); fbk.z = pk2(bv[4] * wb1.x, bv[5] * wb1.y); fbk.w = pk2(bv[6] * wb1.z, bv[7] * wb1.w);
        const bf16x8 af = __builtin_bit_cast(bf16x8, fa), ab = __builtin_bit_cast(bf16x8, fbk);
#pragma unroll
        for (int pt = 0; pt < 4; ++pt) {
            const bf16x8 xf = *(const LAS bf16x8*)(XT + (16 * pt + li) * XT_STRIDE + s0);
            acc[0][pt] = mfma16(af, xf, acc[0][pt]); acc[1][pt] = mfma16(ab, xf, acc[1][pt]);
        }
    }
#pragma unroll
    for (int d = 0; d < 2; ++d) { bf16* So = S + ((size_t)(c * 2 + d) * NHEAD + h) * (HDIM * NST);
#pragma unroll
        for (int pt = 0; pt < 4; ++pt) { v2u o; o.x = pk2(acc[d][pt][0], acc[d][pt][1]); o.y = pk2(acc[d][pt][2], acc[d][pt][3]); *(v2u*)(So + (16 * pt + li) * NST + 16 * wave + 4 * g) = o; } }
}
__device__ __forceinline__ void ssd_scan_item(int e4, const bf16* S, const float* ACS, const float* RB, bf16* SIN) {
    const int e = 4 * e4, dir = e / (NHEAD * HDIM * NST), h = (e / (HDIM * NST)) % NHEAD;
    const size_t cs = (size_t)2 * NHEAD * HDIM * NST;
    f32x4 st = (f32x4){0.f, 0.f, 0.f, 0.f};
#pragma unroll 1
    for (int c0 = 0; c0 < NCH; c0 += 16) {
        v2u sv[16]; float tv[16];
#pragma unroll
        for (int i = 0; i < 16; ++i) { const int c = dir ? (NCH - 1 - (c0 + i)) : (c0 + i);
            sv[i] = *(const v2u*)(S + c * cs + e);
            tv[i] = dir ? RB[(size_t)(c * QCH) * 32 + h] : ACS[(size_t)(c * QCH + QCH - 1) * 32 + h]; }
#pragma unroll
        for (int i = 0; i < 16; ++i) { const int c = dir ? (NCH - 1 - (c0 + i)) : (c0 + i);
            v2u o; o.x = pk2(st.x, st.y); o.y = pk2(st.z, st.w); *(v2u*)(SIN + c * cs + e) = o;
            const f32x4 sc = (f32x4){__uint_as_float(sv[i].x << 16), __uint_as_float(sv[i].x & 0xffff0000u), __uint_as_float(sv[i].y << 16), __uint_as_float(sv[i].y & 0xffff0000u)};
            st = st * __expf(tv[i]) + sc; }
    }
}
__device__ __forceinline__ void ssd_out_unit(int c, int h, const bf16* XBC, const bf16* PS, const float* DTF, const float* DTB, const float* ACS, const float* RB, const bf16* SIN,
                                             float Dskip, bf16* YMIX, float* SSQ, LAS unsigned char* lds, int tid, bool newB) {
    const int lane = tid & 63, wave = tid >> 6, li = lane & 15, g = lane >> 4;
    LAS u16* XT = (LAS u16*)(lds + SSD_XT_OFF);
    LAS u16* Bm = (LAS u16*)(lds + SSD_BM_OFF);
    LAS float* acsL = (LAS float*)(lds + SSD_ARR_OFF);
    LAS float* rbL = acsL + 256; LAS float* dtfL = acsL + 512; LAS float* dtbL = acsL + 768;
    LAS float* cfL = (LAS float*)(lds + SSD_SIN_OFF + 2 * 64 * BM_STRIDE * 2); LAS float* cbL = cfL + 256; LAS float* rfL = cbL + 256; LAS float* rbfL = rfL + 16;
    LAS u16* SF = (LAS u16*)(lds + SSD_SIN_OFF);
    LAS u16* SB = SF + 64 * BM_STRIDE;
    const int t0 = c * QCH, grp = h >> 2;
    __syncthreads();
    ssd_stage_xb(c, h, XBC, lds, tid, newB);
    if (tid < 256) { const size_t o = (size_t)(t0 + tid) * 32 + h; const float LG2E = 1.44269504088896341f;
        const float a_ = ACS[o] * LG2E, r_ = RB[o] * LG2E, df_ = DTF[o], db_ = DTB[o];
        acsL[tid] = a_; rbL[tid] = r_; dtfL[tid] = df_; dtbL[tid] = db_;
        const float rff = ACS[(size_t)(t0 + (tid | 15)) * 32 + h] * LG2E, rfb = RB[(size_t)(t0 + (tid & ~15)) * 32 + h] * LG2E;
        cfL[tid] = __builtin_amdgcn_exp2f(rff - a_) * df_; cbL[tid] = __builtin_amdgcn_exp2f(rfb - r_) * db_;
        if ((tid & 15) == 0) { rfL[tid >> 4] = rff; rbfL[tid >> 4] = rfb; } }
    {
        const bf16* sf = SIN + ((size_t)(c * 2 + 0) * NHEAD + h) * (HDIM * NST);
        const bf16* sb = SIN + ((size_t)(c * 2 + 1) * NHEAD + h) * (HDIM * NST);
#pragma unroll
        for (int i = 0; i < 2; ++i) { const int id = tid + 512 * i, p = id >> 4, nc = id & 15;
            *(LAS v4u*)(SF + p * BM_STRIDE + 8 * nc) = *(const v4u*)(sf + p * NST + 8 * nc);
            *(LAS v4u*)(SB + p * BM_STRIDE + 8 * nc) = *(const v4u*)(sb + p * NST + 8 * nc); }
    }
    bf16x8 cfa[2][4];
#pragma unroll
    for (int lt = 0; lt < 2; ++lt)
#pragma unroll
        for (int kn = 0; kn < 4; ++kn) cfa[lt][kn] = *(const bf16x8*)(XBC + (size_t)(t0 + 32 * wave + 16 * lt + li) * XBCW + SSW + NGRP * NST + grp * NST + 32 * kn + 8 * g);
    __syncthreads();
#pragma unroll
    for (int lt = 0; lt < 2; ++lt) {
        const int l = 32 * wave + 16 * lt + li;
        bf16x8 cf[4];
#pragma unroll
        for (int kn = 0; kn < 4; ++kn) cf[kn] = cfa[lt][kn];
        v2u xwp[4], zwp[4];
#pragma unroll
        for (int pt = 0; pt < 4; ++pt) { xwp[pt] = *(const v2u*)(XBC + (size_t)(t0 + l) * XBCW + h * HDIM + 16 * pt + 4 * g); zwp[pt] = *(const v2u*)(PS + (size_t)(t0 + l) * PSW + h * HDIM + 16 * pt + 4 * g); }
        const float acs_l = acsL[l], rb_l = rbL[l];
        const int jl = __builtin_amdgcn_readfirstlane(2 * wave + lt);
        f32x4 yacc[4];
#pragma unroll
        for (int pt = 0; pt < 4; ++pt) yacc[pt] = (f32x4){0.f, 0.f, 0.f, 0.f};
#pragma unroll 2
        for (int ks = 0; ks < 8; ++ks) {
            bf16x8 bfr[2][4];
#pragma unroll
            for (int st = 0; st < 2; ++st)
#pragma unroll
                for (int kn = 0; kn < 4; ++kn) bfr[st][kn] = *(const LAS bf16x8*)(Bm + (32 * ks + 16 * st + li) * BM_STRIDE + 32 * kn + 8 * g);
            f32x4 cf4[2], cb4[2];
#pragma unroll
            for (int st = 0; st < 2; ++st) { const int s4 = 32 * ks + 16 * st + 4 * g; cf4[st] = *(const LAS f32x4*)(cfL + s4); cb4[st] = *(const LAS f32x4*)(cbL + s4); }
            v2u x0[4], x1[4];
#pragma unroll
            for (int pt = 0; pt < 4; ++pt) { const LAS u16* xr = XT + (16 * pt + li) * XT_STRIDE + 32 * ks + 4 * g; x0[pt] = *(const LAS v2u*)xr; x1[pt] = *(const LAS v2u*)(xr + 16); }
            f32x4 d[2] = {(f32x4){0.f, 0.f, 0.f, 0.f}, (f32x4){0.f, 0.f, 0.f, 0.f}};
#pragma unroll
            for (int kn = 0; kn < 4; ++kn) { d[0] = mfma16(bfr[0][kn], cf[kn], d[0]); d[1] = mfma16(bfr[1][kn], cf[kn], d[1]); }
            unsigned mw[4];
#pragma unroll
            for (int st = 0; st < 2; ++st) {
                const int s4 = 32 * ks + 16 * st + 4 * g;
                float mv[4];
                const int jt = 2 * ks + st;
                if (jt < jl) {
                    const float rw = __builtin_amdgcn_exp2f(acs_l - rfL[jt]);
#pragma unroll
                    for (int r = 0; r < 4; ++r) mv[r] = (d[st][r] * rw) * cf4[st][r];
                } else if (jt > jl) {
                    const float rw = __builtin_amdgcn_exp2f(rb_l - rbfL[jt]);
#pragma unroll
                    for (int r = 0; r < 4; ++r) mv[r] = (d[st][r] * rw) * cb4[st][r];
                } else {
                    const f32x4 as4 = *(const LAS f32x4*)(acsL + s4), rs4 = *(const LAS f32x4*)(rbL + s4), df4 = *(const LAS f32x4*)(dtfL + s4), db4 = *(const LAS f32x4*)(dtbL + s4);
#pragma unroll
                    for (int r = 0; r < 4; ++r) { const int s = s4 + r;
                        const float wfw = (s <= l) ? __builtin_amdgcn_exp2f(acs_l - as4[r]) * df4[r] : 0.f;
                        const float wbw = (s >= l) ? __builtin_amdgcn_exp2f(rb_l - rs4[r]) * db4[r] : 0.f;
                        mv[r] = d[st][r] * (wfw + wbw); }
                }
                mw[2 * st] = pk2(mv[0], mv[1]); mw[2 * st + 1] = pk2(mv[2], mv[3]);
            }
            v4u mfv; mfv.x = mw[0]; mfv.y = mw[1]; mfv.z = mw[2]; mfv.w = mw[3];
            const bf16x8 mfrag = __builtin_bit_cast(bf16x8, mfv);
#pragma unroll
            for (int pt = 0; pt < 4; ++pt) {
                v4u xv; xv.x = x0[pt].x; xv.y = x0[pt].y; xv.z = x1[pt].x; xv.w = x1[pt].y;
                yacc[pt] = mfma16(__builtin_bit_cast(bf16x8, xv), mfrag, yacc[pt]);
            }
        }
        const float ef = __builtin_amdgcn_exp2f(acs_l), eb = __builtin_amdgcn_exp2f(rb_l);
#pragma unroll
        for (int pt = 0; pt < 4; ++pt) {
            f32x4 df = (f32x4){0.f, 0.f, 0.f, 0.f}, db = (f32x4){0.f, 0.f, 0.f, 0.f};
#pragma unroll
            for (int kn = 0; kn < 4; ++kn) {
                const bf16x8 sfr = *(const LAS bf16x8*)(SF + (16 * pt + li) * BM_STRIDE + 32 * kn + 8 * g);
                const bf16x8 sbr = *(const LAS bf16x8*)(SB + (16 * pt + li) * BM_STRIDE + 32 * kn + 8 * g);
                df = mfma16(sfr, cf[kn], df); db = mfma16(sbr, cf[kn], db);
            }
            yacc[pt] = yacc[pt] + df * ef + db * eb;
        }
        const int t = t0 + l;
        float ssq = 0.f;
#pragma unroll
        for (int pt = 0; pt < 4; ++pt) {
            const int p = 16 * pt + 4 * g;
            const v2u xw = xwp[pt], zw = zwp[pt];
            float y0 = (yacc[pt][0] + Dskip * bflo(xw.x)) * silu_f(bflo(zw.x));
            float y1 = (yacc[pt][1] + Dskip * bfhi(xw.x)) * silu_f(bfhi(zw.x));
            float y2 = (yacc[pt][2] + Dskip * bflo(xw.y)) * silu_f(bflo(zw.y));
            float y3 = (yacc[pt][3] + Dskip * bfhi(xw.y)) * silu_f(bfhi(zw.y));
            ssq += (y0 * y0 + y1 * y1) + (y2 * y2 + y3 * y3);
            v2u o; o.x = pk2(y0, y1); o.y = pk2(y2, y3);
            *(v2u*)(YMIX + (size_t)t * DM + HYW + h * HDIM + p) = o;
        }
        ssq += __shfl_xor(ssq, 16); ssq += __shfl_xor(ssq, 32);
        if (g == 0) SSQ[(size_t)t * 32 + h] = ssq;
    }
}
__device__ __forceinline__ void mixer_norm_unit(int tb, const bf16* Z2T, const float* hog, const float* SSQ, const float* sog, bf16* YMIX, LAS unsigned char* lds, int tid) {
    LAS float* red = (LAS float*)lds;
    LAS float* rsh = (LAS float*)(lds + 16640);
    LAS float* rss = rsh + 64;
    LAS u16* tile = (LAS u16*)(lds + 20480);
    constexpr int TS = 264;
    const int t0 = 64 * tb, j = tid & 7, cc = tid >> 3;
    __syncthreads();
    float ps[8];
#pragma unroll
    for (int e = 0; e < 8; ++e) ps[e] = 0.f;
#pragma unroll 16
    for (int cbk = 0; cbk < 32; ++cbk) {
        const v4u v = *(const v4u*)(Z2T + (size_t)(64 * cbk + cc) * SEQ + t0 + 8 * j);
#pragma unroll
        for (int e = 0; e < 4; ++e) { const float a = bflo(v[e]), b = bfhi(v[e]); ps[2 * e] += a * a; ps[2 * e + 1] += b * b; }
    }
#pragma unroll
    for (int e = 0; e < 8; ++e) red[cc * 65 + 8 * j + e] = ps[e];
    __syncthreads();
    if (tid < 64) { float s = 0.f; for (int k = 0; k < 64; ++k) s += red[k * 65 + tid]; rsh[tid] = 1.0f / sqrtf(s * (1.f / HYW) + EPS); }
    { const int tk = tid >> 3, gq = tid & 7; const f32x4 q = *(const f32x4*)(SSQ + (size_t)(t0 + tk) * 32 + 4 * gq); rss[tk * 8 + gq] = 1.0f / sqrtf(((q.x + q.y) + (q.z + q.w)) * (1.f / 256.f) + EPS); }
    v4u cur[4], nxt[4];
#pragma unroll
    for (int i = 0; i < 4; ++i) cur[i] = *(const v4u*)(Z2T + (size_t)(cc + 64 * i) * SEQ + t0 + 8 * j);
#pragma unroll 1
    for (int cb4 = 0; cb4 < 8; ++cb4) {
        if (cb4 + 1 < 8) {
#pragma unroll
            for (int i = 0; i < 4; ++i) nxt[i] = *(const v4u*)(Z2T + (size_t)(256 * (cb4 + 1) + cc + 64 * i) * SEQ + t0 + 8 * j); }
#pragma unroll
        for (int i = 0; i < 4; ++i) { const bool odd = (cc & 1) != 0;
            const unsigned sx = odd ? cur[i].x : cur[i].z, sy = odd ? cur[i].y : cur[i].w;
            const unsigned rx = (unsigned)__builtin_amdgcn_update_dpp(0, (int)sx, 0x128, 0xF, 0xF, true), ry = (unsigned)__builtin_amdgcn_update_dpp(0, (int)sy, 0x128, 0xF, 0xF, true);
            const unsigned lx = odd ? rx : cur[i].x, ly = odd ? ry : cur[i].y, ux = odd ? cur[i].z : rx, uy = odd ? cur[i].w : ry;
            LAS u16* tp = tile + (8 * j + (odd ? 4 : 0)) * TS + (cc & ~1) + 64 * i;
            *(LAS unsigned*)(tp) = (lx & 0xffffu) | (ux << 16); *(LAS unsigned*)(tp + TS) = (lx >> 16) | (ux & 0xffff0000u);
            *(LAS unsigned*)(tp + 2 * TS) = (ly & 0xffffu) | (uy << 16); *(LAS unsigned*)(tp + 3 * TS) = (ly >> 16) | (uy & 0xffff0000u); }
        __syncthreads();
        { const int tk = tid >> 3; const float r = rsh[tk];
#pragma unroll
          for (int i = 0; i < 4; ++i) { const int c8 = (tid & 7) + 8 * i; const v4u w = *(const LAS v4u*)(tile + tk * TS + 8 * c8);
            const f32x4 g0 = *(const f32x4*)(hog + 256 * cb4 + 8 * c8), g1 = *(const f32x4*)(hog + 256 * cb4 + 8 * c8 + 4);
            v4u o; o.x = pk2(bflo(w.x) * r * g0.x, bfhi(w.x) * r * g0.y); o.y = pk2(bflo(w.y) * r * g0.z, bfhi(w.y) * r * g0.w);
            o.z = pk2(bflo(w.z) * r * g1.x, bfhi(w.z) * r * g1.y); o.w = pk2(bflo(w.w) * r * g1.z, bfhi(w.w) * r * g1.w);
            *(v4u*)(YMIX + (size_t)(t0 + tk) * DM + 256 * cb4 + 8 * c8) = o; } }
        __syncthreads();
#pragma unroll
        for (int i = 0; i < 4; ++i) cur[i] = nxt[i];
    }
    const int oc = tid & 255;
    const f32x4 g0 = *(const f32x4*)(sog + 8 * oc), g1 = *(const f32x4*)(sog + 8 * oc + 4);
#pragma unroll 16
    for (int i = 0; i < 32; ++i) { const int tk = (tid >> 8) + 2 * i;
        bf16* ptr = YMIX + (size_t)(t0 + tk) * DM + HYW + 8 * oc; const v4u w = *(const v4u*)ptr; const float r = rss[tk * 8 + (oc >> 5)];
        v4u o; o.x = pk2(bflo(w.x) * r * g0.x, bfhi(w.x) * r * g0.y); o.y = pk2(bflo(w.y) * r * g0.z, bfhi(w.y) * r * g0.w);
        o.z = pk2(bflo(w.z) * r * g1.x, bfhi(w.z) * r * g1.y); o.w = pk2(bflo(w.w) * r * g1.z, bfhi(w.w) * r * g1.w);
        *(v4u*)ptr = o; }
}

#ifndef MK_ONE_LAUNCH
#define MK_ONE_LAUNCH 1
#endif
constexpr int NPH = 12, PH_FINAL = 1 + DEPTH * NPH, PH_TOTAL = PH_FINAL + 1;
struct Args { const float* in[N_INPUTS]; float* out; unsigned char* ws; int ph_lo, ph_hi, use_bar, pad; };

__global__ void __launch_bounds__(512, 2) mk_fwd(Args a) {
    extern __shared__ __attribute__((aligned(16))) unsigned char lds_raw[];
    LAS unsigned char* lds = (LAS unsigned char*)lds_raw;
    const int G = gridDim.x, bid = blockIdx.x;
    const int wave_s = __builtin_amdgcn_readfirstlane((int)threadIdx.x >> 6);
    volatile LAS unsigned* MISC = (volatile LAS unsigned*)(lds + MISC_OFF);
    if (threadIdx.x < 64) MISC[threadIdx.x] = 0u;
    __syncthreads();
    unsigned* ctl = (unsigned*)(a.ws + WS_CTL);
    XcdBarrier bar; bar.bar = ctl + CW_BAR; bar.x = 0; bar.st = MISC + 8;
    if (a.use_bar) bar = xcd_barrier_post(ctl + CW_BAR, MISC + 8);
    const int lo = a.ph_lo, hi = a.ph_hi;
#ifndef MK_C1
#define MK_C1 1
#endif
#ifndef MK_C2
#define MK_C2 1
#endif
#ifndef MK_REP_MASK
#define MK_REP_MASK 0u
#endif
#define REPS(k) ((((unsigned)MK_REP_MASK >> (k)) & 1u) ? 2 : 1)
#define REP_LOOP(k) for (int rep_ = 0; rep_ < REPS(k); ++rep_)
#define REP_SEAM(k) do { if (rep_ + 1 < REPS(k)) xcd_barrier(bar); } while (0)
#ifndef MK_TAPS
#define MK_TAPS 1
#endif
#ifndef MK_PHMASK
#define MK_PHMASK 0xFFFFu
#endif
#define IN(p) (lo <= (p) && (p) < hi)
#define INL(k) (((MK_PHMASK >> (k)) & 1u) && IN(pb + (k)))
#ifndef MK_DBL_BAR
#define MK_DBL_BAR 0
#endif
#define SEAM(p) do { if (IN(p) && IN((p) + 1)) { xcd_barrier(bar); if (MK_DBL_BAR) xcd_barrier(bar); } } while (0)
#define CAS __attribute__((address_space(4)))
#define PHASE_BEGIN \
    const char CAS* kp = (const char CAS*)__builtin_amdgcn_kernarg_segment_ptr(); asm volatile("" : "+s"(kp)); \
    unsigned char* ws = *(unsigned char* const CAS*)(kp + 8 * (N_INPUTS + 1)); \
    unsigned z_ = 0u; asm volatile("" : "+v"(z_)); int wv_ = wave_s; asm volatile("" : "+s"(wv_)); \
    const int tid = wv_ * 64 + (int)__builtin_amdgcn_mbcnt_hi(~0u, __builtin_amdgcn_mbcnt_lo(~0u, z_)); \
    const int lane = tid & 63, wave = wave_s; \
    const int vcu = (G % 8 == 0) ? (bid % 8) * (G / 8) + bid / 8 : bid; \
    const int gw = vcu * 8 + wave, NGW = G * 8; (void)lane; (void)gw; (void)NGW; (void)ws
#ifndef MK_STAG_US
#define MK_STAG_US 0
#endif
#define STAGGER() do { if (MK_STAG_US) { const unsigned long long t0_ = __builtin_amdgcn_s_memrealtime(); const unsigned long long d_ = (unsigned long long)(((bid >> 3) & 7) * MK_STAG_US * 100); while (__builtin_amdgcn_s_memrealtime() - t0_ < d_) __builtin_amdgcn_s_sleep(8); } } while (0)
#define INP(i) (*(const float* const CAS*)(kp + 8 * (i)))
#define OUTP() (*(float* const CAS*)(kp + 8 * N_INPUTS))
#define WSP(T, off) ((T*)(ws + (off)))

    if (IN(0)) {
        PHASE_BEGIN;
        f32x2* TW = WSP(f32x2, WS_TW); f32x2* PW = WSP(f32x2, WS_PW);
        for (int i = bid * 512 + tid; i < 16384 + 8193; i += G * 512) {
            float s, c;
            if (i < 16384) { sincospif((float)i / 8192.0f, &s, &c); TW[i] = (f32x2){c, -s}; }
            else { const int k = i - 16384; sincospif((float)k / 16384.0f, &s, &c); PW[k] = (f32x2){c, -s}; }
        }
    }

#pragma unroll 1
    for (int l = 0; l < DEPTH; ++l) {
        const int pb = 1 + l * NPH;
        if (INL(0)) REP_LOOP(0) {
            PHASE_BEGIN;
            LAS float* scr = (LAS float*)(lds + wave * 16384);
            const float* win = INP(I_WIN) + (size_t)l * DM * NIN; const float* wo = INP(I_WO) + (size_t)l * DM * DM;
            bf16* WIN = WSP(bf16, WS_WIN); bf16* WOUT = WSP(bf16, WS_WOUT);
            const float* gmix = INP(I_NMG) + (size_t)l * DM;
            constexpr int IT_IN = (DM / 64) * (NIN / 32), IT_O = (DM / 64) * (DM / 32);
            for (int it = gw; it < IT_IN + IT_O; it += NGW) {
                int r = it;
                if (r < IT_IN) { transpose_item(win, DM, NIN, WIN, scr, r, lane, gmix); continue; } r -= IT_IN;
                transpose_item(wo, DM, DM, WOUT, scr, r, lane, nullptr);
            }
            if (l == 0) { const float* xin = INP(I_X); bf16* XB = WSP(bf16, WS_XN); float* sa = WSP(float, WS_SSQA);
                for (int m = gw; m < SEQ; m += NGW) prep_row(xin + (size_t)m * DM, XB + (size_t)m * DM, sa + m, lane); }
            else { const int i = bid * 512 + tid; if (i < SEQ) rstd_reduce(WSP(const float, WS_PARTA), WSP(float, WS_SSQA), i);
                   if (bid == 0) for (int i2 = G * 512 + tid; i2 < SEQ; i2 += 512) rstd_reduce(WSP(const float, WS_PARTA), WSP(float, WS_SSQA), i2); }
            const float* w1 = INP(I_PW1) + (size_t)l * 33 * 64; const float* b1 = INP(I_PB1) + (size_t)l * 64;
            const float* w2 = INP(I_PW2) + (size_t)l * 64 * 64; const float* b2 = INP(I_PB2) + (size_t)l * 64;
            const float* w3 = INP(I_PW3) + (size_t)l * 64 * 64; const float* b3 = INP(I_PB3) + (size_t)l * 64;
            const float* sf = INP(I_SF) + (size_t)l * 3 * 64; bf16* H3 = WSP(bf16, WS_H3);
            for (int t = gw; t < SEQ; t += 8 * NGW) posmlp_rows8(t, NGW, w1, b1, w2, b2, w3, b3, sf, H3, lane);
            REP_SEAM(0);
        }
        SEAM(pb + 0);
        const bool early_ = ((bid >> 3) & 1) == 0;
#pragma unroll 1
        for (int step_ = 0; step_ < 2; ++step_) {
          if ((step_ == 0) == early_) {
            if (INL(2)) REP_LOOP(12) {
                PHASE_BEGIN;
                if (rep_) xcd_barrier(bar);
                LAS float* scr = (LAS float*)(lds + wave * 16384);
                const float* wup = INP(I_WUP) + (size_t)l * DM * DFF; const float* wdn = INP(I_WDN) + (size_t)l * DFF * DM;
                bf16* WUP = WSP(bf16, WS_WUP); bf16* WDN = WSP(bf16, WS_WDN);
                const float* gmlp = INP(I_NLG) + (size_t)l * DM;
                constexpr int IT_UP = (DM / 64) * (DFF / 32), IT_DN = (DFF / 64) * (DM / 32);
                __syncthreads();
                for (int it = gw; it < IT_UP + IT_DN; it += NGW) {
                    if (it < IT_UP) transpose_item(wup, DM, DFF, WUP, scr, it, lane, gmlp);
                    else transpose_item(wdn, DFF, DM, WDN, scr, it - IT_UP, lane, nullptr);
                }
                if (MK_TAPS) taps_gemm(INP(I_WOUTF) + (size_t)l * 64 * NTAP, WSP(bf16, WS_H3), WSP(bf16, WS_HT), gw, NGW, lane);
                __syncthreads();
            }
          } else {
            if (INL(1)) REP_LOOP(1) {
                PHASE_BEGIN;
                pg8::Gemm g{WSP(bf16, WS_WIN), WSP(bf16, WS_XN), 3 * HYW, SEQ, DM}; pg8::StaticOrder S; S.init(3 * HYW, SEQ, G, bid);
                pg8::EpiBf16P<0, 2> E{WSP(bf16, WS_PT), SEQ, WSP(const float, WS_SSQA)};
                pg8::gemm_phase<pg8::EpiBf16P<0, 2>, pg8::StaticOrder, true, true>(lds, g, S, E, tid);
                REP_SEAM(1);
            }
            if (INL(2)) REP_LOOP(2) {
                PHASE_BEGIN;
                if (rep_) xcd_barrier(bar);
                pg8::Gemm g{WSP(bf16, WS_XN), WSP(bf16, WS_WIN) + (size_t)3 * HYW * DM, SEQ, PSW, DM}; pg8::StaticOrder S; S.init(SEQ, PSW, G, bid);
                pg8::EpiBf16P<0, 1> E{WSP(bf16, WS_PS), PSW, WSP(const float, WS_SSQA)};
                pg8::gemm_phase<pg8::EpiBf16P<0, 1>, pg8::StaticOrder, true, true>(lds, g, S, E, tid);
            }
          }
        }
        SEAM(pb + 2);
        const bool ssm_first_ = ((bid >> 3) & 1) == 0;
#pragma unroll 1
        for (int step_ = 0; step_ < 2; ++step_) {
        if ((step_ == 0) == ssm_first_) {
        if (MK_C1 && INL(3)) REP_LOOP(13) {
            PHASE_BEGIN;
            if (rep_) xcd_barrier(bar);
            LAS unsigned* wctr = (LAS unsigned*)(lds + MISC_OFF + 64);
            __syncthreads(); if (tid == 0) *wctr = 0u; __syncthreads();
            if (wave < 4) for (int tile = vcu * 4 + wave; tile < SEQ / 16; tile += G * 4) ssm_dt_tile(tile, WSP(bf16, WS_XN), WSP(bf16, WS_WIN) + (size_t)(3 * HYW + PSW) * DM, WSP(const float, WS_SSQA), WSP(float, WS_DTRAW), lane);
            { const float* cw = INP(I_SCW) + (size_t)l * 3 * XBCW; const float* cb = INP(I_SCB) + (size_t)l * XBCW;
              for (;;) { unsigned k = 0u; if (lane == 0) k = __hip_atomic_fetch_add(wctr, 1u, __ATOMIC_RELAXED, __HIP_MEMORY_SCOPE_WORKGROUP);
                  k = (unsigned)__builtin_amdgcn_readfirstlane((int)k);
                  const unsigned idx = (unsigned)bid + k * (unsigned)G;
                  if (idx >= 512u * 512u / 64u) break;
                  ssm_conv_item(WSP(bf16, WS_PS), cw, cb, WSP(bf16, WS_XBC), (int)(idx * 64u) + lane); } }
            __syncthreads();
        }
        } else {
        if (MK_C2 && INL(3)) REP_LOOP(3) {
            PHASE_BEGIN;
            if (rep_) xcd_barrier(bar);
            const float* cw = INP(I_HCW) + (size_t)l * 3 * 3 * HYW; const float* cb = INP(I_HCB) + (size_t)l * 3 * HYW; const float* sk = INP(I_SKIP) + (size_t)l * 2 * HYW;
            __syncthreads(); fft_fill_twl(WSP(f32x2, WS_TW), WSP(f32x2, WS_PW), lds, tid); __syncthreads();
            for (int c = bid; c < HYW; c += G) hyena_channel(c, WSP(bf16, WS_PT), WSP(bf16, WS_HT), cw, cb, sk, WSP(bf16, WS_Z2T), (f32x4*)(ws + WS_GSCR + (size_t)bid * GSCR_PER_WG), lds, tid);
        }
        } }
        SEAM(pb + 3);
        if (INL(4)) REP_LOOP(4) { PHASE_BEGIN; if (rep_) xcd_barrier(bar);
            for (int pr = vcu; pr < NCH * (NHEAD / 4); pr += G)
#pragma unroll 1
                for (int hh = 0; hh < 4; ++hh) { int c_ = pr >> 3, h_ = 4 * (pr & 7) + hh; asm volatile("" : "+s"(c_), "+s"(h_));
                    ssd_states_unit(c_, h_, WSP(bf16, WS_XBC), WSP(float, WS_DTRAW), INP(I_ALOG) + (size_t)l * 64, INP(I_DTB) + (size_t)l * 64,
                                                                       WSP(float, WS_DTF), WSP(float, WS_DTB), WSP(float, WS_ACS), WSP(float, WS_RB), WSP(bf16, WS_S), lds, tid, hh == 0); } }
        SEAM(pb + 4);
        if (INL(5)) REP_LOOP(5) { PHASE_BEGIN; if (rep_) xcd_barrier(bar);
            for (int e4 = bid * 512 + tid; e4 < 2 * NHEAD * HDIM * NST / 4; e4 += G * 512) ssd_scan_item(e4, WSP(bf16, WS_S), WSP(float, WS_ACS), WSP(float, WS_RB), WSP(bf16, WS_SIN)); }
        SEAM(pb + 5);
        if (INL(6)) REP_LOOP(6) { PHASE_BEGIN; if (rep_) xcd_barrier(bar); const float* sd = INP(I_SD) + (size_t)l * NHEAD;
            for (int pr = vcu; pr < NCH * (NHEAD / 4); pr += G)
#pragma unroll 1
                for (int hh = 0; hh < 4; ++hh) { int c_ = pr >> 3, h_ = 4 * (pr & 7) + hh; asm volatile("" : "+s"(c_), "+s"(h_));
                    ssd_out_unit(c_, h_, WSP(bf16, WS_XBC), WSP(bf16, WS_PS), WSP(float, WS_DTF), WSP(float, WS_DTB), WSP(float, WS_ACS), WSP(float, WS_RB),
                                                                    WSP(bf16, WS_SIN), sd[h_], WSP(bf16, WS_YMIX), WSP(float, WS_SSQ), lds, tid, hh == 0); } }
        SEAM(pb + 6);
        if (INL(7)) { PHASE_BEGIN;
            for (int tb = bid; tb < SEQ / 64; tb += G) mixer_norm_unit(tb, WSP(bf16, WS_Z2T), INP(I_HOG) + (size_t)l * HYW, WSP(float, WS_SSQ), INP(I_SOG) + (size_t)l * SSW, WSP(bf16, WS_YMIX), lds, tid); }
        SEAM(pb + 7);
        if (INL(8)) REP_LOOP(8) { PHASE_BEGIN; if (rep_) xcd_barrier(bar);
            STAGGER();
            pg8::Gemm g{WSP(bf16, WS_YMIX), WSP(bf16, WS_WOUT), SEQ, DM, DM}; pg8::StaticOrder S; S.init(SEQ, DM, G, bid);
            pg8::EpiRes E{WSP(bf16, WS_XN), WSP(float, WS_X), WSP(float, WS_PARTB), DM, SEQ, 0};
            pg8::gemm_phase<pg8::EpiRes, pg8::StaticOrder, true, true>(lds, g, S, E, tid); }
        SEAM(pb + 8);
        if (INL(10)) REP_LOOP(10) { PHASE_BEGIN; if (rep_) xcd_barrier(bar);
            pg8::Gemm g{WSP(bf16, WS_XN), WSP(bf16, WS_WUP), SEQ, DFF, DM}; pg8::StaticOrder S; S.init(SEQ, DFF, G, bid);
            { pg8::Unit u0; int last = -1;
#pragma unroll 1
              for (int i = 0; S.next(i, u0); ++i) if (u0.pm != last) { last = u0.pm; if (tid < 256) rstd_reduce(WSP(const float, WS_PARTB), WSP(float, WS_SSQB), u0.pm * 256 + tid); }
              __syncthreads(); }
            pg8::EpiBf16P<1, 1> E{WSP(bf16, WS_H), DFF, WSP(const float, WS_SSQB)};
            pg8::gemm_phase<pg8::EpiBf16P<1, 1>, pg8::StaticOrder, true, true>(lds, g, S, E, tid); }
        SEAM(pb + 10);
        if (INL(11)) REP_LOOP(11) { PHASE_BEGIN; if (rep_) xcd_barrier(bar);
            STAGGER();
            pg8::Gemm g{WSP(bf16, WS_H), WSP(bf16, WS_WDN), SEQ, DM, DFF}; pg8::StaticOrder S; S.init(SEQ, DM, G, bid);
            pg8::EpiRes E{WSP(bf16, WS_XN), WSP(float, WS_X), WSP(float, WS_PARTA), DM, SEQ, 0};
            pg8::gemm_phase<pg8::EpiRes, pg8::StaticOrder, true, true>(lds, g, S, E, tid); }
        SEAM(pb + 11);
    }
    if (IN(PH_FINAL)) { PHASE_BEGIN; const bf16* X = WSP(const bf16, WS_XN); float* out = OUTP();
        for (int m = gw; m < SEQ; m += NGW) rms_row_b(X + (size_t)m * DM, INP(I_FNG), out + (size_t)m * DM, lane); }
#undef IN
#undef INL
#undef SEAM
}

extern "C" void kernel_launch(void* const* d_in, const int* in_sizes, int n_in, void* d_out, int out_size, void* d_ws, size_t ws_size, hipStream_t stream) {
    static int grid = 0;
    if (grid == 0) {
        if (n_in != N_INPUTS || in_sizes[0] != SEQ * DM || out_size != SEQ * DM || ws_size < WS_END) {
            fprintf(stderr, "kernel_launch: unexpected problem: n_in %d in0 %d out %d ws %zu (need %zu)\n", n_in, n_in > 0 ? in_sizes[0] : -1, out_size, ws_size, (size_t)WS_END); grid = -1; return; }
        int dev = 0, cus = 0;
        if (hipGetDevice(&dev) != hipSuccess || hipDeviceGetAttribute(&cus, hipDeviceAttributeMultiprocessorCount, dev) != hipSuccess) { grid = -1; return; }
        if (hipFuncSetAttribute((const void*)mk_fwd, hipFuncAttributeMaxDynamicSharedMemorySize, LDS_BYTES) != hipSuccess) { fprintf(stderr, "kernel_launch: hipFuncSetAttribute failed\n"); grid = -1; return; }
        int per_cu = 0;
        if (hipOccupancyMaxActiveBlocksPerMultiprocessor(&per_cu, (const void*)mk_fwd, 512, LDS_BYTES) != hipSuccess || per_cu < 1) fprintf(stderr, "kernel_launch: occupancy query reports %d\n", per_cu);
        (void)hipGetLastError();
        grid = cus;
    }
    if (grid < 0) return;
    if (hipMemsetAsync((char*)d_ws + WS_CTL, 0, CTL_ZERO_BYTES, stream) != hipSuccess) return;
    Args a{};
    for (int i = 0; i < N_INPUTS; ++i) a.in[i] = (const float*)d_in[i];
    a.out = (float*)d_out; a.ws = (unsigned char*)d_ws; a.pad = 0;
#if MK_ONE_LAUNCH
    a.ph_lo = 0; a.ph_hi = PH_TOTAL; a.use_bar = 1;
    hipLaunchKernelGGL(mk_fwd, dim3(grid), dim3(512), LDS_BYTES, stream, a);
#else
    for (int p = 0; p < PH_TOTAL; ++p) { a.ph_lo = p; a.ph_hi = p + 1; a.use_bar = 0;
        hipLaunchKernelGGL(mk_fwd, dim3(grid), dim3(512), LDS_BYTES, stream, a); }
#endif
}
```
